# Optimizing an MI355X kernel written in HIP

```python
import jax
import jax.numpy as jnp
from jax import lax
import numpy as np

D_MODEL = 2048
BATCH = 8
SEQ = 4096
DEPTH = 1

GRID_W = 64
CTX_LEN = 256
MIX_WIDTH = D_MODEL
RWKV_WIDTH = D_MODEL // 2
RWKV_HEAD = 64
RWKV_HEADS = RWKV_WIDTH // RWKV_HEAD
W_LORA = 64
A_LORA = 64
G_LORA = 128
GMLP_WIDTH = MIX_WIDTH - RWKV_WIDTH
GMLP_GROUPS = 16
GMLP_GROUP = GMLP_WIDTH // GMLP_GROUPS
CHUNK = 128
D_FF = 5632
N_MOD = 9
RWKV_IN = 3 * RWKV_WIDTH + W_LORA + A_LORA + G_LORA
IN_WIDTH = RWKV_IN + 2 * GMLP_WIDTH
RWKV_SPLITS = (RWKV_WIDTH, 2 * RWKV_WIDTH, 3 * RWKV_WIDTH,
               3 * RWKV_WIDTH + W_LORA, 3 * RWKV_WIDTH + W_LORA + A_LORA)
ALPHA = (2.0 * DEPTH) ** 0.25
BETA = (8.0 * DEPTH) ** -0.25
LN_EPS = 1e-5
GN_EPS = 64e-5

kernel_name = "hymba_rwkv7_gmlp_macaron_deepnorm_dit"


def layer_norm(x, g, b, eps=LN_EPS):
    xf = x.astype(jnp.float32)
    mu = jnp.mean(xf, axis=-1, keepdims=True)
    var = jnp.mean(jnp.square(xf - mu), axis=-1, keepdims=True)
    return ((xf - mu) * lax.rsqrt(var + eps) * g + b).astype(x.dtype)


def modulate(h, mod, j):
    return h * (1.0 + mod[3 * j + 1]) + mod[3 * j], mod[3 * j + 2]


def swiglu(h, wi, wo):
    gate, up = jnp.split(h @ wi, 2, axis=-1)
    return (jax.nn.silu(gate) * up) @ wo


def heads(t):
    return t.reshape(t.shape[0], t.shape[1], RWKV_HEADS, RWKV_HEAD)


def grid_shift(p, rows):
    b, s, ch = p.shape
    q = p.reshape(b, rows, GRID_W, ch // 4, 4)
    zc = jnp.zeros_like(q[:, :, :1, :, 0])
    zr = jnp.zeros_like(q[:, :1, :, :, 0])
    left = jnp.concatenate([zc, q[:, :, :-1, :, 0]], axis=2)
    right = jnp.concatenate([q[:, :, 1:, :, 1], zc], axis=2)
    up = jnp.concatenate([zr, q[:, :-1, :, :, 2]], axis=1)
    down = jnp.concatenate([q[:, 1:, :, :, 3], zr], axis=1)
    return jnp.stack([left, right, up, down], axis=-1).reshape(b, s, ch)


def seq_shift(p):
    prev = jnp.pad(p, ((0, 0), (1, 0), (0, 0)))[:, :-1]
    nxt = jnp.pad(p, ((0, 0), (0, 1), (0, 0)))[:, 1:]
    even = (jnp.arange(p.shape[-1]) % 2) == 0
    return jnp.where(even, prev, nxt)


def rwkv_prepare(rw, shifted, mu, w0, w_up, a0, a_up, g_up, k_k, k_a):
    xs = rw + (shifted - rw) * mu
    r, k, v, w_lo, a_lo, g_lo = jnp.split(xs, RWKV_SPLITS, axis=-1)
    g = jax.nn.sigmoid(g_lo) @ g_up
    kk = heads(k * k_k).astype(jnp.float32)
    kk = kk / jnp.maximum(jnp.sqrt(jnp.sum(kk * kk, axis=-1, keepdims=True)), 1e-12)
    dirs = []
    for d in range(2):
        w = -jax.nn.softplus(-(w0[d] + jnp.tanh(w_lo) @ w_up[d])) - 0.5
        iclr = jax.nn.sigmoid(a0[d] + a_lo @ a_up[d])
        k_d = k * (1.0 + (iclr - 1.0) * k_a)
        decay = heads(jnp.exp(-jnp.exp(w.astype(jnp.float32))))
        dirs.append((decay, heads(k_d), -kk, kk * heads(iclr).astype(jnp.float32)))
    return heads(r), heads(v), g, dirs


def wkv_scan(r, v, decay, k, a, b, s0, reverse):
    def step(s, inp):
        r_t, v_t, w_t, k_t, a_t, b_t = inp
        sa = jnp.einsum('bhvk,bhk->bhv', s, a_t)
        s = (s * w_t[:, :, None, :] + sa[..., None] * b_t[:, :, None, :]
             + v_t[..., None] * k_t[:, :, None, :])
        return s, jnp.einsum('bhvk,bhk->bhv', s, r_t)
    xs = tuple(jnp.swapaxes(t.astype(jnp.float32), 0, 1) for t in (r, v, decay, k, a, b))
    s_fin, ys = lax.scan(step, s0, xs, reverse=reverse)
    return s_fin, jnp.swapaxes(ys, 0, 1)


def rwkv_output(r, v, g, dirs, ys, r_k, gn_g, gn_b, dtype):
    y = ys[0] + ys[1]
    mu = jnp.mean(y, axis=-1, keepdims=True)
    var = jnp.mean(jnp.square(y - mu), axis=-1, keepdims=True)
    bsz, t = y.shape[0], y.shape[1]
    yn = ((y - mu) * lax.rsqrt(var + GN_EPS)).reshape(bsz, t, RWKV_WIDTH) * gn_g + gn_b
    rf, vf = r.astype(jnp.float32), v.astype(jnp.float32)
    bonus = sum(jnp.sum(rf * dd[1].astype(jnp.float32) * r_k, axis=-1, keepdims=True) * vf
                for dd in dirs)
    out = (yn + bonus.reshape(bsz, t, RWKV_WIDTH)) * g.astype(jnp.float32)
    return out.astype(dtype)


def gmlp_mix(gm, ln_g, ln_b, ws, bs):
    bsz, t, _ = gm.shape
    u, v = jnp.split(jax.nn.gelu(gm), 2, axis=-1)
    v = v.reshape(bsz, t // CHUNK, CHUNK, GMLP_GROUPS, GMLP_GROUP)
    v = layer_norm(v, ln_g.reshape(GMLP_GROUPS, GMLP_GROUP), ln_b.reshape(GMLP_GROUPS, GMLP_GROUP))
    mixed = jnp.einsum('gpq,bnqgd->bnpgd', ws, v) + bs.T[None, None, :, :, None]
    return u * mixed.reshape(bsz, t, GMLP_WIDTH)


def token_mixer(h_x, h_c, rows, with_ctx_out, w_in, mu_shift, w0, w_up, a0, a_up, g_up,
                k_k, k_a, r_k, gn_g, gn_b, gm_ln_g, gm_ln_b, gm_ws, gm_bs, w_out):
    p_x = h_x @ w_in
    p_c = h_c @ w_in
    rw_x, gm_x = p_x[..., :RWKV_IN], p_x[..., RWKV_IN:]
    rw_c, gm_c = p_c[..., :RWKV_IN], p_c[..., RWKV_IN:]
    rparams = (mu_shift, w0, w_up, a0, a_up, g_up, k_k, k_a)
    r_c, v_c, g_c, dirs_c = rwkv_prepare(rw_c, seq_shift(rw_c), *rparams)
    r_x, v_x, g_x, dirs_x = rwkv_prepare(rw_x, grid_shift(rw_x, rows), *rparams)
    s_zero = jnp.zeros((h_x.shape[0], RWKV_HEADS, RWKV_HEAD, RWKV_HEAD), jnp.float32)
    ys_x, ys_c = [], []
    for d in range(2):
        s_c, y_c = wkv_scan(r_c, v_c, *dirs_c[d], s_zero, reverse=(d == 1))
        _, y_x = wkv_scan(r_x, v_x, *dirs_x[d], s_c, reverse=(d == 1))
        ys_c.append(y_c)
        ys_x.append(y_x)
    out_x = jnp.concatenate([
        rwkv_output(r_x, v_x, g_x, dirs_x, ys_x, r_k, gn_g, gn_b, h_x.dtype),
        gmlp_mix(gm_x, gm_ln_g, gm_ln_b, gm_ws, gm_bs)], axis=-1) @ w_out
    out_c = None
    if with_ctx_out:
        out_c = jnp.concatenate([
            rwkv_output(r_c, v_c, g_c, dirs_c, ys_c, r_k, gn_g, gn_b, h_c.dtype),
            gmlp_mix(gm_c, gm_ln_g, gm_ln_b, gm_ws, gm_bs)], axis=-1) @ w_out
    return out_x, out_c


def setup_inputs(seed: int = 0) -> dict:
    key = jax.random.key(seed)
    ks = jax.random.split(key, 32)
    f32 = jnp.float32
    L, D = DEPTH, D_MODEL

    def nrm(k, shape, scale):
        return jax.random.normal(k, shape, f32) * scale

    w0_base = jnp.linspace(-6.0, -1.0, RWKV_WIDTH, dtype=f32)
    return {
        "x": nrm(ks[0], (BATCH, SEQ, D), 1.0),
        "c": nrm(ks[1], (BATCH, D), 1.0),
        "ctx": nrm(ks[2], (BATCH, CTX_LEN, D), 1.0),
        "c_ctx": nrm(ks[3], (D,), 1.0),
        "w_ada": nrm(ks[4], (L, D, N_MOD * D), 0.5 * D ** -0.5),
        "b_ada": nrm(ks[5], (L, N_MOD * D), 0.02),
        "ln_g": 1.0 + nrm(ks[6], (L, 3, D), 0.02),
        "ln_b": nrm(ks[7], (L, 3, D), 0.02),
        "ffn_a_wi": nrm(ks[8], (L, D, 2 * D_FF), D ** -0.5),
        "ffn_a_wo": nrm(ks[9], (L, D_FF, D), BETA * D_FF ** -0.5),
        "ffn_b_wi": nrm(ks[10], (L, D, 2 * D_FF), D ** -0.5),
        "ffn_b_wo": nrm(ks[11], (L, D_FF, D), BETA * D_FF ** -0.5),
        "w_in": nrm(ks[12], (L, D, IN_WIDTH), D ** -0.5),
        "mu_shift": jax.random.uniform(ks[13], (L, RWKV_IN), f32),
        "w0": w0_base + nrm(ks[14], (L, 2, RWKV_WIDTH), 0.1),
        "w_up": nrm(ks[15], (L, 2, W_LORA, RWKV_WIDTH), 0.1 * W_LORA ** -0.5),
        "a0": nrm(ks[16], (L, 2, RWKV_WIDTH), 0.1),
        "a_up": nrm(ks[17], (L, 2, A_LORA, RWKV_WIDTH), A_LORA ** -0.5),
        "g_up": nrm(ks[18], (L, G_LORA, RWKV_WIDTH), G_LORA ** -0.5),
        "k_k": 0.85 + nrm(ks[19], (L, RWKV_WIDTH), 0.02),
        "k_a": 1.0 + nrm(ks[20], (L, RWKV_WIDTH), 0.02),
        "r_k": nrm(ks[21], (L, RWKV_HEADS, RWKV_HEAD), 0.1),
        "gn_g": 1.0 + nrm(ks[22], (L, RWKV_WIDTH), 0.02),
        "gn_b": nrm(ks[23], (L, RWKV_WIDTH), 0.02),
        "gm_ln_g": 1.0 + nrm(ks[24], (L, GMLP_WIDTH), 0.02),
        "gm_ln_b": nrm(ks[25], (L, GMLP_WIDTH), 0.02),
        "gm_ws": nrm(ks[26], (L, GMLP_GROUPS, CHUNK, CHUNK), CHUNK ** -0.5),
        "gm_bs": 1.0 + nrm(ks[27], (L, GMLP_GROUPS, CHUNK), 0.02),
        "w_out": nrm(ks[28], (L, MIX_WIDTH, D), BETA * MIX_WIDTH ** -0.5),
    }


def reference(x, c, ctx, c_ctx, w_ada, b_ada, ln_g, ln_b, ffn_a_wi, ffn_a_wo, ffn_b_wi,
              ffn_b_wo, w_in, mu_shift, w0, w_up, a0, a_up, g_up, k_k, k_a, r_k, gn_g, gn_b,
              gm_ln_g, gm_ln_b, gm_ws, gm_bs, w_out):
    bsz, seq_len, d = x.shape
    rows = seq_len // GRID_W
    cx = ctx
    for i in range(DEPTH):
        last = i == DEPTH - 1
        mod_x = (jax.nn.silu(c) @ w_ada[i] + b_ada[i]).reshape(bsz, N_MOD, d).transpose(1, 0, 2)[:, :, None, :]
        mod_c = (jax.nn.silu(c_ctx) @ w_ada[i] + b_ada[i]).reshape(N_MOD, 1, 1, d)

        hx, gx = modulate(x, mod_x, 0)
        hc, gc = modulate(cx, mod_c, 0)
        x = layer_norm(ALPHA * x + 0.5 * gx * swiglu(hx, ffn_a_wi[i], ffn_a_wo[i]), ln_g[i, 0], ln_b[i, 0])
        cx = layer_norm(ALPHA * cx + 0.5 * gc * swiglu(hc, ffn_a_wi[i], ffn_a_wo[i]), ln_g[i, 0], ln_b[i, 0])

        hx, gx = modulate(x, mod_x, 1)
        hc, gc = modulate(cx, mod_c, 1)
        out_x, out_c = token_mixer(hx, hc, rows, not last, w_in[i], mu_shift[i], w0[i], w_up[i],
                                   a0[i], a_up[i], g_up[i], k_k[i], k_a[i], r_k[i], gn_g[i], gn_b[i],
                                   gm_ln_g[i], gm_ln_b[i], gm_ws[i], gm_bs[i], w_out[i])
        x = layer_norm(ALPHA * x + gx * out_x, ln_g[i, 1], ln_b[i, 1])
        if not last:
            cx = layer_norm(ALPHA * cx + gc * out_c, ln_g[i, 1], ln_b[i, 1])

        hx, gx = modulate(x, mod_x, 2)
        x = layer_norm(ALPHA * x + 0.5 * gx * swiglu(hx, ffn_b_wi[i], ffn_b_wo[i]), ln_g[i, 2], ln_b[i, 2])
        if not last:
            hc, gc = modulate(cx, mod_c, 2)
            cx = layer_norm(ALPHA * cx + 0.5 * gc * swiglu(hc, ffn_b_wi[i], ffn_b_wo[i]), ln_g[i, 2], ln_b[i, 2])
    return x
```

```cpp
#include <hip/hip_runtime.h>
#include <hip/hip_cooperative_groups.h>
#include <cstdio>
namespace cg = cooperative_groups;

#ifndef SPLIT_LAUNCH
#define SPLIT_LAUNCH 0
#endif

#ifndef PHMASK
#define PHMASK 0xFFFF
#endif
#define PH_ON(n) (((PHMASK) >> (n)) & 1)
#ifndef DUPMASK
#define DUPMASK 0
#endif
#define NREP(n) ((((DUPMASK) >> (n)) & 1) ? 2 : 1)
#define LAS __attribute__((address_space(3)))
typedef unsigned short bf16_t;
typedef unsigned short f16_t;
typedef short bf16x8 __attribute__((ext_vector_type(8)));
typedef float f32x4 __attribute__((ext_vector_type(4)));
typedef float f32x2 __attribute__((ext_vector_type(2)));
typedef unsigned u32x4 __attribute__((ext_vector_type(4)));
typedef unsigned u32x2 __attribute__((ext_vector_type(2)));
typedef _Float16 h16x2 __attribute__((ext_vector_type(2)));
typedef _Float16 h16x4 __attribute__((ext_vector_type(4)));
typedef _Float16 h16x8 __attribute__((ext_vector_type(8)));

constexpr int D = 2048, NB = 8, SEQ = 4096, CTXL = 256;
constexpr int MX = NB * SEQ, MC = NB * CTXL, MT = MX + MC;
constexpr int DFF = 5632, NWI = 2 * DFF, INW = 5376, RIN = 3328, RW = 1024, NH = 16, HD = 64;
constexpr int MODW = 9 * D;
constexpr int NLORA = 5 * RW, KLORA = 256;
constexpr float ALPHA = 1.189207115002721f;
constexpr float LN_EPS = 1e-5f, GN_EPS = 64e-5f;

constexpr size_t MiB = 1u << 20;
constexpr size_t WS_MODV = 1 * MiB;
constexpr size_t WS_ST1 = 2 * MiB;
constexpr size_t WS_ST2 = 2 * MiB + 512 * 1024;
constexpr size_t WS_WSB = 3 * MiB;
constexpr size_t WS_LORAB = 4 * MiB;
constexpr size_t WS_LBIAS = 6 * MiB + 512 * 1024;
constexpr size_t WS_WIN = 7 * MiB;
constexpr size_t WS_WOUT = 28 * MiB;
constexpr size_t WS_WIA = 36 * MiB;
constexpr size_t WS_WOA = 80 * MiB;
constexpr size_t WS_Y1C = 102 * MiB;
constexpr size_t WS_R0 = 118 * MiB;
constexpr size_t WS_R1 = 254 * MiB;
constexpr size_t WS_ALORA = WS_R1 + (size_t)MT * INW * 2;
constexpr size_t WS_R2 = 628 * MiB;
constexpr size_t WS_PART = WS_R2;
constexpr size_t WS_VT = WS_R2 + (size_t)MT * 3072 * 2;
constexpr size_t WS_YSC = WS_VT;
constexpr size_t WS_WIB = WS_R2;
constexpr size_t WS_WOB = WS_R2 + 44 * MiB;
constexpr size_t WS_END = WS_YSC + (size_t)2 * MX * RW * 2;
static_assert(WS_END <= 1024 * MiB, "ws map");
static_assert(WS_R1 + (size_t)MT * DFF * 2 <= WS_R2, "R1");
static_assert(WS_ALORA + (size_t)MT * 256 * 2 <= WS_R2, "alora");

constexpr int LDS_BYTES = 143360;

typedef __bf16 bf16v2 __attribute__((ext_vector_type(2)));
__device__ __forceinline__ unsigned cvt_pk_bf16(float lo, float hi) { const f32x2 v = (f32x2){lo, hi}; const bf16v2 b = __builtin_convertvector(v, bf16v2); return __builtin_bit_cast(unsigned, b); }
__device__ __forceinline__ unsigned pk_f16(float lo, float hi) { h16x2 v; v.x = (_Float16)lo; v.y = (_Float16)hi; return __builtin_bit_cast(unsigned, v); }
__device__ __forceinline__ float sigm(float x) { return __builtin_amdgcn_rcpf(1.0f + __expf(-x)); }
__device__ __forceinline__ float siluf(float x) { return x * sigm(x); }
__device__ __forceinline__ float gelu_t(float x) { return x * sigm(1.5957691216057308f * (x + 0.044715f * x * x * x)); }
__device__ __forceinline__ float tanh_f(float x) { return 2.0f * sigm(2.0f * x) - 1.0f; }
template <int CTRL> __device__ __forceinline__ float dpp_f(float x) {
    return __builtin_bit_cast(float, __builtin_amdgcn_update_dpp(0, __builtin_bit_cast(int, x), CTRL, 0xF, 0xF, false));
}
template <int CTRL> __device__ __forceinline__ float dpp_fz(float x) {
    return __builtin_bit_cast(float, __builtin_amdgcn_update_dpp(0, __builtin_bit_cast(int, x), CTRL, 0xF, 0xF, true));
}
template <int CTRL> __device__ __forceinline__ unsigned dpp_u(unsigned x) {
    return (unsigned)__builtin_amdgcn_update_dpp(0, (int)x, CTRL, 0xF, 0xF, false);
}
constexpr int DPP_XOR1 = 0xB1, DPP_XOR2 = 0x4E, DPP_HALF_MIRROR = 0x141, DPP_MIRROR = 0x140;
__device__ __forceinline__ float wave_sum(float v) {
    v += dpp_f<DPP_XOR1>(v); v += dpp_f<DPP_XOR2>(v); v += dpp_f<DPP_HALF_MIRROR>(v); v += dpp_f<DPP_MIRROR>(v);
    v += __shfl_xor(v, 16); v += __shfl_xor(v, 32);
    return v;
}
__device__ __forceinline__ void h8_to_f(const u32x4 v, float* f) {
    const h16x8 h = __builtin_bit_cast(h16x8, v);
#pragma unroll
    for (int j = 0; j < 8; ++j) f[j] = (float)h[j];
}

namespace pg8 {
constexpr int BM = 256, BK = 64, HALF = 128, HTB = HALF * BK * 2, STAGE_BYTES = 8 * HTB, NXCD = 8, WGM = 8;
__host__ __device__ __forceinline__ int lds_byte(int r, int c) { const int st = (r >> 4) * 2 + (c >> 5), rr = r & 15, cc = c & 31, ob = rr * 64 + cc * 2; return st * 1024 + (ob ^ (((ob >> 9) & 1) << 5)); }
__host__ __device__ __forceinline__ void stage_rc(int b, int& R, int& C) { const int st = b / 1024, sb = b % 1024, swz = sb ^ (((sb >> 9) & 1) << 5); R = (st >> 1) * 16 + swz / 64; C = (st & 1) * 32 + (swz % 64) / 2; }
__host__ __device__ __forceinline__ int perm32(int rho) { const int n = rho >> 4, i = rho & 15; return 8 * (i >> 2) + 4 * n + (i & 3); }

struct Unit { int pm, pn, ks; };
struct Gemm { const bf16_t* A; const bf16_t* Bt; int M, N, K, ld; };

struct StaticOrder {
    static constexpr bool OPAQUE_K = false;
    int nM, nN, nwg, G, c;
    __device__ void init(int M, int N, int G_, int c_) { nM = M / BM; nN = N / BM; nwg = nM * nN; G = G_; c = c_; }
    __device__ bool next(int i, Unit& u) const {
        const long L = (long)i * G + c; if (L >= nwg) return false;
        int wgid = (int)L; { const int q = nwg / NXCD, r = nwg % NXCD, xcd = wgid % NXCD, off = wgid / NXCD; wgid = (xcd < r ? xcd * (q + 1) : r * (q + 1) + (xcd - r) * q) + off; }
        const int nig = WGM * nN, gid = wgid / nig, fm = gid * WGM, gsz = (nM - fm) < WGM ? (nM - fm) : WGM;
        u.pm = fm + ((wgid % nig) % gsz); u.pn = (wgid % nig) / gsz; u.ks = 0; return true;
    }
};
struct RectOrder {
    static constexpr bool OPAQUE_K = false;
    StaticOrder so; int n1, n2m, n2n, pm0;
    __device__ void init(int M1, int N1, int n2m_, int n2n_, int G_, int c_) { so.init(M1, N1, G_, c_); n1 = so.nwg; n2m = n2m_; n2n = n2n_; pm0 = so.nM; }
    __device__ bool next(int i, Unit& u) const {
        const long L = (long)i * so.G + so.c;
        if (L < n1) return so.next(i, u);
        const int idx = (int)(L - n1); if (idx >= n2m * n2n) return false;
        u.pm = pm0 + idx % n2m; u.pn = idx / n2m; u.ks = 0; return true;
    }
};
struct LoraOrder {
    static constexpr bool OPAQUE_K = true;
    StaticOrder so;
    __device__ bool next(int i, Unit& u) const { if (!so.next(i, u)) return false; u.ks = u.pn >= 16 ? 1 : 0; return true; }
};
struct SplitOrder {
    static constexpr bool OPAQUE_K = false;
    int nm, nn, ns, pm0, G, c;
    __device__ bool next(int i, Unit& u) const {
        const long L = (long)i * G + c; if (L >= (long)nm * nn * ns) return false;
        const int idx = (int)L; u.ks = idx % ns; const int tile = idx / ns; u.pm = pm0 + tile % nm; u.pn = tile / nm; return true;
    }
};

template <class Epi, class Order>
__device__ __forceinline__ void gemm_phase(LAS unsigned char* lds, const Gemm g, const Order& S, const Epi& E) {
    const int tid = threadIdx.x, wid = __builtin_amdgcn_readfirstlane(tid >> 6), lane = tid & 63, wr = wid >> 2, wc = wid & 3, fr = lane & 15, fq = lane >> 4;
    int K = g.K; if (Order::OPAQUE_K) asm volatile("" : "+s"(K));
    const int nt = K / BK;
    unsigned voffA[2], voffB[2];
#pragma unroll
    for (int i = 0; i < 2; ++i) { int R, C; stage_rc(tid * 16 + i * 8192, R, C); const int Rb = Epi::PERM ? ((R & ~31) + perm32(R & 31)) : R;
        voffA[i] = (unsigned)(R * g.ld + C) * 2u; voffB[i] = (unsigned)(Rb * g.ld + C) * 2u; }
    const size_t kstep = (size_t)(BK * 2);
    const size_t hstep = (size_t)HALF * g.ld * 2;
    const size_t sstep = (size_t)K * 2;
    const size_t tstep = 2 * hstep;
    const unsigned ldsw = (unsigned)wid * 1024u;
    const int aoff = lds_byte(wr * 64 + fr, fq * 8), boff = lds_byte(wc * 32 + fr, fq * 8);
#define PG8_SA(b, h) (((b) * 2 + (h)) * HTB)
#define PG8_SB(b, h) ((4 + (b) * 2 + (h)) * HTB)
#define PG8_STAGE(bufoff, gbase, voff) do { _Pragma("unroll") for (int _i = 0; _i < 2; ++_i) \
        __builtin_amdgcn_global_load_lds((const unsigned*)((const char*)(gbase) + (voff)[_i]), (LAS unsigned*)(lds + (bufoff) + ldsw + _i * 8192), 16, 0, 0); } while (0)
#define PG8_LDA(dst, b, h) do { _Pragma("unroll") for (int m = 0; m < 4; ++m) _Pragma("unroll") for (int k = 0; k < 2; ++k) dst[m][k] = *(const LAS bf16x8*)(lds + PG8_SA(b, h) + aoff + m * 2048 + k * 1024); } while (0)
#define PG8_LDB(dst, b, h) do { _Pragma("unroll") for (int n = 0; n < 2; ++n) _Pragma("unroll") for (int k = 0; k < 2; ++k) dst[n][k] = *(const LAS bf16x8*)(lds + PG8_SB(b, h) + boff + n * 2048 + k * 1024); } while (0)
#define PG8_MMA(ai, bj, At, Bt) do { __builtin_amdgcn_s_setprio(1); _Pragma("unroll") for (int m = 0; m < 4; ++m) _Pragma("unroll") for (int n = 0; n < 2; ++n) _Pragma("unroll") for (int k = 0; k < 2; ++k) \
        acc[ai][bj][m][n] = __builtin_amdgcn_mfma_f32_16x16x32_bf16(Bt[n][k], At[m][k], acc[ai][bj][m][n], 0, 0, 0); __builtin_amdgcn_s_setprio(0); } while (0)
#define PG8_WAIT_V(n) asm volatile("s_waitcnt vmcnt(" #n ")" ::: "memory")
#define PG8_WAIT_L(n) asm volatile("s_waitcnt lgkmcnt(" #n ")" ::: "memory")
#define PG8_BAR __builtin_amdgcn_s_barrier()
#define PG8_SCHED __builtin_amdgcn_sched_barrier(0)
    Unit cur, nxt; int ui = 0;
    if (!S.next(0, cur)) return;
    f32x4 acc[2][2][4][2];
#pragma unroll
    for (int a = 0; a < 2; ++a)
#pragma unroll
        for (int b = 0; b < 2; ++b)
#pragma unroll
            for (int m = 0; m < 4; ++m)
#pragma unroll
                for (int n = 0; n < 2; ++n) acc[a][b][m][n] = (f32x4){0.f, 0.f, 0.f, 0.f};
    bf16x8 At[4][2], B0[2][2], B1[2][2];
    const char* cA = (const char*)g.A + (size_t)cur.pm * tstep + (size_t)cur.ks * sstep; const char* cB = (const char*)g.Bt + (size_t)cur.pn * tstep + (size_t)cur.ks * sstep;
    PG8_STAGE(PG8_SB(0, 0), cB, voffB); PG8_STAGE(PG8_SA(0, 0), cA, voffA); PG8_STAGE(PG8_SB(0, 1), cB + hstep, voffB); PG8_STAGE(PG8_SA(0, 1), cA + hstep, voffA);
    if (wr == 1) PG8_BAR;
    PG8_WAIT_V(4); PG8_BAR;
    PG8_STAGE(PG8_SB(1, 0), cB + kstep, voffB); PG8_STAGE(PG8_SA(1, 0), cA + kstep, voffA); PG8_STAGE(PG8_SB(1, 1), cB + hstep + kstep, voffB);
    PG8_WAIT_V(6); PG8_BAR;
    for (;;) {
        const bool has_next = S.next(ui + 1, nxt);
        const char* nA = has_next ? (const char*)g.A + (size_t)nxt.pm * tstep + (size_t)nxt.ks * sstep : cA; const char* nB = has_next ? (const char*)g.Bt + (size_t)nxt.pn * tstep + (size_t)nxt.ks * sstep : cB;
#pragma nounroll
        for (int t = 0; t < nt; t += 2) {
            const bool last = (t == nt - 2);
            const char* a1 = cA + (size_t)(t + 1) * kstep;
            const char* a2 = last ? nA : cA + (size_t)(t + 2) * kstep; const char* b2 = last ? nB : cB + (size_t)(t + 2) * kstep;
            const char* a3 = a2 + kstep; const char* b3 = b2 + kstep;
            PG8_LDB(B0, 0, 0); PG8_SCHED; PG8_LDA(At, 0, 0); PG8_STAGE(PG8_SA(1, 1), a1 + hstep, voffA);
            PG8_WAIT_L(8); PG8_BAR; PG8_WAIT_L(0); PG8_MMA(0, 0, At, B0); PG8_BAR; PG8_SCHED;
            PG8_LDB(B1, 0, 1); PG8_STAGE(PG8_SB(0, 0), b2, voffB);
            PG8_BAR; PG8_WAIT_L(0); PG8_MMA(0, 1, At, B1); PG8_BAR;
            PG8_LDA(At, 0, 1); PG8_STAGE(PG8_SA(0, 0), a2, voffA);
            PG8_BAR; PG8_WAIT_L(0); PG8_MMA(1, 0, At, B0); PG8_BAR; PG8_SCHED;
            PG8_STAGE(PG8_SB(0, 1), b2 + hstep, voffB);
            PG8_WAIT_V(6); PG8_BAR; PG8_MMA(1, 1, At, B1); PG8_BAR;
            PG8_LDB(B0, 1, 0); PG8_SCHED; PG8_LDA(At, 1, 0); PG8_STAGE(PG8_SA(0, 1), a2 + hstep, voffA);
            PG8_WAIT_L(8); PG8_BAR; PG8_WAIT_L(0); PG8_MMA(0, 0, At, B0); PG8_BAR; PG8_SCHED;
            PG8_LDB(B1, 1, 1); PG8_STAGE(PG8_SB(1, 0), b3, voffB);
            PG8_BAR; PG8_WAIT_L(0); PG8_MMA(0, 1, At, B1); PG8_BAR;
            PG8_LDA(At, 1, 1); PG8_STAGE(PG8_SA(1, 0), a3, voffA);
            PG8_BAR; PG8_WAIT_L(0); PG8_MMA(1, 0, At, B0); PG8_BAR; PG8_SCHED;
            PG8_STAGE(PG8_SB(1, 1), b3 + hstep, voffB);
            PG8_WAIT_V(6); PG8_BAR; PG8_MMA(1, 1, At, B1); PG8_BAR;
        }
        E(acc, cur, wr, wc, fr, fq);
        if (!has_next) break;
#pragma unroll
        for (int a = 0; a < 2; ++a)
#pragma unroll
            for (int b = 0; b < 2; ++b)
#pragma unroll
                for (int m = 0; m < 4; ++m)
#pragma unroll
                    for (int n = 0; n < 2; ++n) acc[a][b][m][n] = (f32x4){0.f, 0.f, 0.f, 0.f};
        cur = nxt; cA = nA; cB = nB; ++ui;
    }
    PG8_WAIT_V(0);
    if (wr == 0) PG8_BAR;
    PG8_BAR;
#undef PG8_SA
#undef PG8_SB
#undef PG8_STAGE
#undef PG8_LDA
#undef PG8_LDB
#undef PG8_MMA
#undef PG8_WAIT_V
#undef PG8_WAIT_L
#undef PG8_BAR
#undef PG8_SCHED
}
}

struct EpiSwiglu {
    static constexpr bool PERM = true;
    bf16_t* O;
    __device__ __forceinline__ void operator()(const f32x4 (&acc)[2][2][4][2], const pg8::Unit& u, int wr, int wc, int fr, int fq) const {
        const int row0 = u.pm * 256 + wr * 64 + fr, col0 = u.pn * 128 + wc * 32 + 8 * fq;
#pragma unroll
        for (int ai = 0; ai < 2; ++ai)
#pragma unroll
            for (int m = 0; m < 4; ++m) {
                bf16_t* rowp = O + (size_t)(row0 + ai * 128 + m * 16) * DFF + col0;
                const f32x4 g0 = acc[ai][0][m][0], g1 = acc[ai][0][m][1], u0 = acc[ai][1][m][0], u1 = acc[ai][1][m][1];
                u32x4 w;
                w.x = cvt_pk_bf16(siluf(g0[0]) * u0[0], siluf(g0[1]) * u0[1]); w.y = cvt_pk_bf16(siluf(g0[2]) * u0[2], siluf(g0[3]) * u0[3]);
                w.z = cvt_pk_bf16(siluf(g1[0]) * u1[0], siluf(g1[1]) * u1[1]); w.w = cvt_pk_bf16(siluf(g1[2]) * u1[2], siluf(g1[3]) * u1[3]);
                *(u32x4*)rowp = w;
            }
    }
};
struct EpiF16 {
    static constexpr bool PERM = true;
    f16_t* O; int ldc;
    __device__ __forceinline__ void operator()(const f32x4 (&acc)[2][2][4][2], const pg8::Unit& u, int wr, int wc, int fr, int fq) const {
        const int row0 = u.pm * 256 + wr * 64 + fr, col0 = u.pn * 256 + wc * 32 + 8 * fq;
#pragma unroll
        for (int ai = 0; ai < 2; ++ai)
#pragma unroll
            for (int m = 0; m < 4; ++m) {
                f16_t* rowp = O + (size_t)(row0 + ai * 128 + m * 16) * ldc + col0;
#pragma unroll
                for (int bj = 0; bj < 2; ++bj) { const f32x4 v0 = acc[ai][bj][m][0], v1 = acc[ai][bj][m][1];
                    u32x4 w; w.x = pk_f16(v0[0], v0[1]); w.y = pk_f16(v0[2], v0[3]); w.z = pk_f16(v1[0], v1[1]); w.w = pk_f16(v1[2], v1[3]);
                    *(u32x4*)(rowp + bj * 128) = w; }
            }
    }
};
struct EpiLora {
    static constexpr bool PERM = true;
    f16_t* L; const float* bias;
    __device__ __forceinline__ void operator()(const f32x4 (&acc)[2][2][4][2], const pg8::Unit& u, int wr, int wc, int fr, int fq) const {
        const int reg = u.pn >> 2;
        const int row0 = u.pm * 256 + wr * 64 + fr, cc0 = (u.pn & 3) * 256 + wc * 32 + 8 * fq;
        f16_t* base = L + (size_t)reg * MT * RW + (size_t)row0 * RW + cc0;
        const float* bp = bias + reg * RW + cc0;
        const float sc = reg < 2 ? 0.6065306597126334f : 1.0f;
        const bool act = reg < 4;
        f32x4 bva[2][2];
#pragma unroll
        for (int bj = 0; bj < 2; ++bj)
#pragma unroll
            for (int n = 0; n < 2; ++n) bva[bj][n] = *(const f32x4*)(bp + bj * 128 + 4 * n);
#pragma unroll
        for (int bj = 0; bj < 2; ++bj)
#pragma unroll
            for (int n = 0; n < 2; ++n) {
                const f32x4 bv = bva[bj][n];
#pragma unroll
                for (int ai = 0; ai < 2; ++ai)
#pragma unroll
                    for (int m = 0; m < 4; ++m) {
                        f32x4 v = acc[ai][bj][m][n] + bv;
#pragma unroll
                        for (int j = 0; j < 4; ++j) { const float sg = sc * sigm(v[j]); v[j] = act ? sg : v[j]; }
                        u32x2 w; w.x = pk_f16(v[0], v[1]); w.y = pk_f16(v[2], v[3]);
                        *(u32x2*)(base + (size_t)(ai * 128 + m * 16) * RW + bj * 128 + 4 * n) = w;
                    }
            }
    }
};
struct EpiPartial {
    static constexpr bool PERM = false;
    float* part;
    __device__ __forceinline__ void operator()(const f32x4 (&acc)[2][2][4][2], const pg8::Unit& u, int wr, int wc, int fr, int fq) const {
        float* base = part + (size_t)u.ks * MC * D + (size_t)((u.pm - MX / 256) * 256 + wr * 64 + fr) * D + u.pn * 256 + wc * 32 + 4 * fq;
#pragma unroll
        for (int ai = 0; ai < 2; ++ai)
#pragma unroll
            for (int m = 0; m < 4; ++m)
#pragma unroll
                for (int bj = 0; bj < 2; ++bj)
#pragma unroll
                    for (int n = 0; n < 2; ++n) *(f32x4*)(base + (size_t)(ai * 128 + m * 16) * D + bj * 128 + n * 16) = acc[ai][bj][m][n];
    }
};
struct EpiResid {
    static constexpr bool PERM = false;
    const float* Xx; const float* Xc; float* Yx; float* Yc;
    const f32x2* stats; const float* lg; const float* lb;
    const float* modv; int gslot; float gscale;
    __device__ __forceinline__ void operator()(const f32x4 (&acc)[2][2][4][2], const pg8::Unit& u, int wr, int wc, int fr, int fq) const {
        const bool isx = u.pm < (MX / 256);
        const int mr = isx ? (u.pm >> 4) : 8;
        const float* gate = modv + (size_t)mr * MODW + gslot * D;
        const int lrow0 = (isx ? u.pm : u.pm - MX / 256) * 256 + wr * 64 + fr;
        const float* src = isx ? Xx : Xc; float* dst = isx ? Yx : Yc;
        const int grow0 = u.pm * 256 + wr * 64 + fr;
        f32x2 stv[2][4];
#pragma unroll
        for (int ai = 0; ai < 2; ++ai)
#pragma unroll
            for (int m = 0; m < 4; ++m) stv[ai][m] = stats ? stats[grow0 + ai * 128 + m * 16] : (f32x2){0.f, 1.f};
#pragma unroll
        for (int bj = 0; bj < 2; ++bj)
#pragma unroll
            for (int n = 0; n < 2; ++n) {
                const int col = u.pn * 256 + bj * 128 + wc * 32 + n * 16 + 4 * fq;
                const f32x4 gv = *(const f32x4*)(gate + col) * gscale;
                f32x4 lgv = (f32x4){1.f, 1.f, 1.f, 1.f}, lbv = (f32x4){0.f, 0.f, 0.f, 0.f};
                if (stats) { lgv = *(const f32x4*)(lg + col); lbv = *(const f32x4*)(lb + col); }
                f32x4 xv[2][4];
#pragma unroll
                for (int ai = 0; ai < 2; ++ai)
#pragma unroll
                    for (int m = 0; m < 4; ++m) xv[ai][m] = *(const f32x4*)(src + (size_t)(lrow0 + ai * 128 + m * 16) * D + col);
#pragma unroll
                for (int ai = 0; ai < 2; ++ai)
#pragma unroll
                    for (int m = 0; m < 4; ++m) {
                        const size_t off = (size_t)(lrow0 + ai * 128 + m * 16) * D + col;
                        f32x4 x = xv[ai][m];
                        if (stats) x = (x - stv[ai][m].x) * stv[ai][m].y * lgv + lbv;
                        *(f32x4*)(dst + off) = ALPHA * x + gv * acc[ai][bj][m][n];
                    }
            }
    }
};

#define XB_TMO      128
#define XB_XCNT(j)  (256  + 64 * (j))
#define XB_XSUB(j)  (1280 + 64 * (j))
#define XB_XGEN(j)  (2304 + 64 * (j))
#define XB_TOP      3328
#define XB_TOPGEN   3392
#define XCD_BAR_WORDS 3456
#define XB_SPIN_CAP (1u << 18)

__device__ __forceinline__ unsigned xb_ld(unsigned* p)              { return __hip_atomic_load(p, __ATOMIC_RELAXED, __HIP_MEMORY_SCOPE_AGENT); }
__device__ __forceinline__ unsigned xb_add(unsigned* p, unsigned v) { return __hip_atomic_fetch_add(p, v, __ATOMIC_RELAXED, __HIP_MEMORY_SCOPE_AGENT); }
__device__ __forceinline__ unsigned xb_xcc_id() { return (unsigned)__builtin_amdgcn_s_getreg((3 << 11) | 20) & 0xFu; }
#define XB_SPIN(cond, bar) do { unsigned _sp = 0; while (cond) { __builtin_amdgcn_s_sleep(1); \
    if ((++_sp & 255u) == 0u) { if (xb_ld(&(bar)[XB_TMO])) break; if (_sp > XB_SPIN_CAP) { atomicAdd(&(bar)[XB_TMO], 1u); break; } } } } while (0)

struct XcdBarrier {
    unsigned* bar; unsigned x;
    volatile LAS unsigned* st;
};

__device__ __forceinline__ XcdBarrier xcd_barrier_post(unsigned* bar, volatile LAS unsigned* st) {
    XcdBarrier b; b.bar = bar; b.x = xb_xcc_id(); b.st = st;
    if (threadIdx.x == 0) (void)xb_add(&bar[XB_XCNT(b.x)], 1u);
    return b;
}
__device__ __forceinline__ void xcd_barrier_complete(unsigned* bar, unsigned x, unsigned& nloc, unsigned& nx) {
    const unsigned G = gridDim.x * gridDim.y * gridDim.z;
    unsigned sum, cnt, mine, sp = 0u;
    for (;;) {
        sum = 0u; cnt = 0u; mine = 0u;
#pragma unroll
        for (unsigned j = 0; j < 16; ++j) { const unsigned c = xb_ld(&bar[XB_XCNT(j)]); sum += c; cnt += (c > 0u) ? 1u : 0u; mine = (j == x) ? c : mine; }
        if (sum == G) break;
        __builtin_amdgcn_s_sleep(1);
        if ((++sp & 255u) == 0u) { if (xb_ld(&bar[XB_TMO])) break; if (sp > XB_SPIN_CAP) { atomicAdd(&bar[XB_TMO], 1u); break; } }
    }
    nloc = mine > 0u ? mine : 1u; nx = cnt > 0u ? cnt : 1u;
}

__device__ __forceinline__ void xcd_barrier(const XcdBarrier& b) {
    asm volatile("s_waitcnt vmcnt(0)" ::: "memory");
    __syncthreads();
    if (threadIdx.x == 0) {
        unsigned* bar = b.bar;
        __builtin_amdgcn_s_waitcnt(0);
        unsigned nloc = b.st[0], nx = b.st[1];
        if (nloc == 0u) { xcd_barrier_complete(bar, b.x, nloc, nx); b.st[0] = nloc; b.st[1] = nx; }
        const unsigned old = xb_add(&bar[XB_XSUB(b.x)], 1u);
        const unsigned gen = old / nloc;
        if (old + 1u == (gen + 1u) * nloc) {
            __builtin_amdgcn_fence(__ATOMIC_RELEASE, "agent");
            asm volatile("s_waitcnt vmcnt(0)" ::: "memory");
            const unsigned og = xb_add(&bar[XB_TOP], 1u);
            const unsigned tg = og / nx;
            if (og + 1u == (tg + 1u) * nx) xb_add(&bar[XB_TOPGEN], 1u);
            else XB_SPIN(xb_ld(&bar[XB_TOPGEN]) == tg, bar);
            __builtin_amdgcn_fence(__ATOMIC_ACQUIRE, "agent");
            xb_add(&bar[XB_XGEN(b.x)], 1u);
            asm volatile("s_waitcnt vmcnt(0)" ::: "memory");
        } else {
            XB_SPIN(xb_ld(&bar[XB_XGEN(b.x)]) == gen, bar);
            __builtin_amdgcn_fence(__ATOMIC_ACQUIRE, "agent");
            asm volatile("s_waitcnt vmcnt(0)" ::: "memory");
        }
    }
    __syncthreads();
}

struct Params { const float* in[29]; float* out; unsigned char* ws; int ph_lo, ph_hi; };
enum { I_X = 0, I_C, I_CTX, I_CCTX, I_WADA, I_BADA, I_LNG, I_LNB, I_WIA, I_WOA, I_WIB, I_WOB, I_WIN, I_MU, I_W0, I_WUP, I_A0, I_AUP, I_GUP, I_KK, I_KA, I_RK, I_GNG, I_GNB, I_GMG, I_GMB, I_GMWS, I_GMBS, I_WOUT };

template <bool SWI>
__device__ __forceinline__ void transpose_item(const float* W, int K, int N, bf16_t* WT, LAS float* scr, int item, int lane) {
    const int nblk = N / 32, kb = item / nblk, nb = item % nblk, k0 = 64 * kb, n0 = 32 * nb;
    float wv[32];
#pragma unroll
    for (int i = 0; i < 32; ++i) wv[i] = __builtin_nontemporal_load(W + (size_t)(k0 + 2 * i + (lane >> 5)) * N + n0 + (lane & 31));
#pragma unroll
    for (int i = 0; i < 32; ++i) scr[(2 * i + (lane >> 5)) * 33 + (lane & 31)] = wv[i];
    asm volatile("s_waitcnt lgkmcnt(0)" ::: "memory");
    int r0 = n0;
    if (SWI) { const int bj = n0 / DFF, j = n0 - bj * DFF; r0 = (j >> 7) * 256 + bj * 128 + (j & 127); }
    const int c = lane & 7;
#pragma unroll
    for (int j = 0; j < 4; ++j) { const int n = (lane >> 3) + 8 * j; const LAS float* s = scr + (8 * c) * 33 + n;
        u32x4 o; o.x = cvt_pk_bf16(s[0 * 33], s[1 * 33]); o.y = cvt_pk_bf16(s[2 * 33], s[3 * 33]); o.z = cvt_pk_bf16(s[4 * 33], s[5 * 33]); o.w = cvt_pk_bf16(s[6 * 33], s[7 * 33]);
        *(u32x4*)(WT + (size_t)(r0 + n) * K + k0 + 8 * c) = o; }
    asm volatile("s_waitcnt lgkmcnt(0)" ::: "memory");
}

template <int PH>
__device__ __forceinline__ void ln_pass(const Params& p, LAS unsigned char* lds, unsigned char* ws, float* Yx, float* Yc, const float* modv, const float* lng, const float* lnb, f32x2* st1, f32x2* st2, bf16_t* R0, int gw, int NGW, int lane, int wave) {
    constexpr int ph = PH;
            const int j = ph == 4 ? 1 : 2; const int rows = ph == 4 ? MT : MX;
            f32x2* st = ph == 4 ? st1 : st2;
            const float* lg = lng + (j - 1) * D; const float* lb = lnb + (j - 1) * D;
            LAS float* Lg = (LAS float*)lds; LAS float* Lb = Lg + D; LAS float* Ls = Lb + D; LAS float* Lt = Ls + D;
            { const int tid_ = (int)threadIdx.x; *(LAS f32x4*)(Lg + tid_ * 4) = *(const f32x4*)(lg + tid_ * 4); *(LAS f32x4*)(Lb + tid_ * 4) = *(const f32x4*)(lb + tid_ * 4); }
            int cur_mr = -1;
            f32x4 nv[8];
            if (gw < rows) { const float* y0 = gw < MX ? Yx + (size_t)gw * D : p.in[I_CTX] + (size_t)(gw - MX) * D;
#pragma unroll
                for (int q = 0; q < 8; ++q) nv[q] = *(const f32x4*)(y0 + q * 256 + lane * 4); }
            for (int m = gw; m < rows; m += NGW) {
                const bool isx = m < MX; const int mr = isx ? (m >> 12) : 8;
                if (mr != cur_mr) {
                    const float* sh = modv + (size_t)mr * MODW + 3 * j * D; const int tid_ = (int)threadIdx.x;
                    __syncthreads();
                    *(LAS f32x4*)(Lt + tid_ * 4) = *(const f32x4*)(sh + tid_ * 4); *(LAS f32x4*)(Ls + tid_ * 4) = *(const f32x4*)(sh + D + tid_ * 4);
                    __syncthreads();
                    cur_mr = mr;
                }
                f32x4 v[8]; float s = 0.f;
#pragma unroll
                for (int q = 0; q < 8; ++q) v[q] = nv[q];
                { const int mn = m + NGW < rows ? m + NGW : m; const float* yn = mn < MX ? Yx + (size_t)mn * D : p.in[I_CTX] + (size_t)(mn - MX) * D;
#pragma unroll
                  for (int q = 0; q < 8; ++q) nv[q] = *(const f32x4*)(yn + q * 256 + lane * 4); }
                if (!isx) {
#pragma unroll
                    for (int q = 0; q < 8; ++q) {
                        const float* pp = (const float*)(ws + WS_PART) + (size_t)(m - MX) * D + q * 256 + lane * 4;
                        const f32x4 ps = (*(const f32x4*)pp + *(const f32x4*)(pp + (size_t)MC * D)) + (*(const f32x4*)(pp + (size_t)2 * MC * D) + *(const f32x4*)(pp + (size_t)3 * MC * D));
                        v[q] = ALPHA * v[q] + 0.5f * *(const f32x4*)(modv + (size_t)8 * MODW + 2 * D + q * 256 + lane * 4) * ps; }
                }
#pragma unroll
                for (int q = 0; q < 8; ++q) s += (v[q][0] + v[q][1]) + (v[q][2] + v[q][3]);
                const float mean = wave_sum(s) * (1.0f / D); float s2 = 0.f;
#pragma unroll
                for (int q = 0; q < 8; ++q) { v[q] = v[q] - mean; s2 += (v[q][0] * v[q][0] + v[q][1] * v[q][1]) + (v[q][2] * v[q][2] + v[q][3] * v[q][3]); }
                const float rstd = 1.0f / sqrtf(wave_sum(s2) * (1.0f / D) + LN_EPS);
                if (lane == 0) st[m] = (f32x2){mean, rstd};
                bf16_t* o = R0 + (size_t)m * D;
#pragma unroll
                for (int hq = 0; hq < 2; ++hq) {
                    f32x4 g4[4], b4[4], s4[4], t4[4];
#pragma unroll
                    for (int u = 0; u < 4; ++u) { const int c = (hq * 4 + u) * 256 + lane * 4; g4[u] = *(const LAS f32x4*)(Lg + c); b4[u] = *(const LAS f32x4*)(Lb + c); s4[u] = *(const LAS f32x4*)(Ls + c); t4[u] = *(const LAS f32x4*)(Lt + c); }
#pragma unroll
                    for (int u = 0; u < 4; ++u) { const int q = hq * 4 + u, c = q * 256 + lane * 4;
                        const f32x4 xn = v[q] * rstd * g4[u] + b4[u];
                        const f32x4 h = xn * (1.0f + s4[u]) + t4[u];
                        u32x2 w; w.x = cvt_pk_bf16(h[0], h[1]); w.y = cvt_pk_bf16(h[2], h[3]); *(u32x2*)(o + c) = w; }
                }
            }
            if (ph == 12) {
                __syncthreads();
                LAS float* scr = (LAS float*)(lds + wave * 16384);
                constexpr int I_1 = (D / 64) * (NWI / 32), I_2 = (DFF / 64) * (D / 32);
                for (int it = gw; it < I_1 + I_2; it += NGW) {
                    if (it < I_1) transpose_item<true>(p.in[I_WIB], D, NWI, (bf16_t*)(ws + WS_WIB), scr, it, lane);
                    else transpose_item<false>(p.in[I_WOB], DFF, D, (bf16_t*)(ws + WS_WOB), scr, it - I_1, lane);
                }
            }
}

__global__ void __launch_bounds__(512, 2) fwd_megakernel(Params p) {
    extern __shared__ __attribute__((aligned(16))) unsigned char lds_raw[];
    LAS unsigned char* lds = (LAS unsigned char*)lds_raw;
    const int tid = threadIdx.x, lane = tid & 63, wave = __builtin_amdgcn_readfirstlane(tid >> 6);
    const int G = gridDim.x, bid = blockIdx.x;
    const int gw = bid * 8 + wave, NGW = G * 8;
    unsigned char* ws = p.ws;
    float* modv = (float*)(ws + WS_MODV);
    f32x2* st1 = (f32x2*)(ws + WS_ST1); f32x2* st2 = (f32x2*)(ws + WS_ST2);
    bf16_t* R0 = (bf16_t*)(ws + WS_R0);
    float* Yx = p.out; float* Yc = (float*)(ws + WS_Y1C);
    const float* lng = p.in[I_LNG]; const float* lnb = p.in[I_LNB];

    cg::grid_group grid = cg::this_grid();
    const int lo = p.ph_lo, hi = p.ph_hi;
    volatile LAS unsigned* bst = (volatile LAS unsigned*)(lds + LDS_BYTES - 16);
    if (tid < 4) bst[tid] = 0u;
    __syncthreads();
    XcdBarrier xbar = xcd_barrier_post((unsigned*)ws, bst);
    if (hi > 1000) grid.sync();
#define IN(k) (lo <= (k) && (k) < hi)
#define SEAM(k) do { if (IN(k) && IN((k) + 1)) xcd_barrier(xbar); } while (0)
        if (PH_ON(0) && IN(0)) for (int rep_ = 0; rep_ < NREP(0); ++rep_) { if (rep_) xcd_barrier(xbar);
            LAS float* scr = (LAS float*)(lds + wave * 16384);
            constexpr int I_1 = (D / 64) * (NWI / 32), I_2 = (DFF / 64) * (D / 32), I_3 = (D / 64) * (INW / 32), I_4 = (D / 64) * (D / 32);
            for (int it = gw; it < I_1 + I_2 + I_3 + I_4; it += NGW) {
                int r = it;
                if (r < I_1) { transpose_item<true>(p.in[I_WIA], D, NWI, (bf16_t*)(ws + WS_WIA), scr, r, lane); continue; } r -= I_1;
                if (r < I_2) { transpose_item<false>(p.in[I_WOA], DFF, D, (bf16_t*)(ws + WS_WOA), scr, r, lane); continue; } r -= I_2;
                if (r < I_3) { transpose_item<false>(p.in[I_WIN], D, INW, (bf16_t*)(ws + WS_WIN), scr, r, lane); continue; } r -= I_3;
                transpose_item<false>(p.in[I_WOUT], D, D, (bf16_t*)(ws + WS_WOUT), scr, r, lane);
            }
            {
                bf16_t* LB = (bf16_t*)(ws + WS_LORAB);
                const float* wup = p.in[I_WUP]; const float* aup = p.in[I_AUP]; const float* gup = p.in[I_GUP];
                for (int i = bid * 512 + tid; i < NLORA * KLORA; i += G * 512) {
                    const int n = i >> 8, k = i & 255, reg = n >> 10, cc = n & 1023; float v = 0.f;
                    if (reg < 2) { if (k < 64) v = wup[((size_t)reg * 64 + k) * RW + cc]; }
                    else if (reg < 4) { if (k >= 64 && k < 128) v = aup[((size_t)(reg - 2) * 64 + (k - 64)) * RW + cc]; }
                    else { if (k >= 128) v = gup[(size_t)(k - 128) * RW + cc]; }
                    LB[i] = (bf16_t)(cvt_pk_bf16(v, 0.f) & 0xffffu);
                }
                float* LBI = (float*)(ws + WS_LBIAS);
                for (int i = bid * 512 + tid; i < NLORA; i += G * 512) LBI[i] = i < 2048 ? p.in[I_W0][i] : (i < 4096 ? p.in[I_A0][i - 2048] : 0.f);
                bf16_t* WSB = (bf16_t*)(ws + WS_WSB); const float* gws = p.in[I_GMWS];
                for (int i = bid * 512 + tid; i < 16 * 128 * 128; i += G * 512) WSB[i] = (bf16_t)(cvt_pk_bf16(gws[i], 0.f) & 0xffffu);
            }
            __syncthreads();
            {
                LAS float* sb = (LAS float*)lds;
                LAS float* red = (LAS float*)(lds + 9 * 2048 * 4);
                for (int i = tid; i < 9 * D; i += 512) { const int r = i >> 11, k = i & 2047; const float v = r < 8 ? p.in[I_C][r * D + k] : p.in[I_CCTX][k]; sb[i] = siluf(v); }
                __syncthreads();
                const float* wada = p.in[I_WADA]; const float* bada = p.in[I_BADA];
                for (int tk = bid; tk < MODW / 32; tk += G) {
                    const int c0 = tk * 32, col = lane & 31, kh = lane >> 5;
                    float a[9];
#pragma unroll
                    for (int r = 0; r < 9; ++r) a[r] = 0.f;
                    const float* wp = wada + (size_t)(wave * 256 + kh) * MODW + c0 + col;
                    const LAS float* sp = sb + wave * 256 + kh;
                    for (int k16 = 0; k16 < 256; k16 += 32) {
                        float wv[16];
#pragma unroll
                        for (int j = 0; j < 16; ++j) wv[j] = __builtin_nontemporal_load(wp + (size_t)(k16 + 2 * j) * MODW);
#pragma unroll
                        for (int j = 0; j < 16; ++j)
#pragma unroll
                            for (int r = 0; r < 9; ++r) a[r] += sp[r * D + k16 + 2 * j] * wv[j];
                    }
#pragma unroll
                    for (int r = 0; r < 9; ++r) { a[r] += __shfl_xor(a[r], 32); if (lane < 32) red[(wave * 9 + r) * 32 + col] = a[r]; }
                    __syncthreads();
                    for (int i = tid; i < 9 * 32; i += 512) { const int r = i >> 5, l = i & 31; float sacc = 0.f;
#pragma unroll
                        for (int w = 0; w < 8; ++w) sacc += red[(w * 9 + r) * 32 + l];
                        modv[(size_t)r * MODW + c0 + l] = sacc + bada[c0 + l]; }
                    __syncthreads();
                }
            }
        } SEAM(0);

        if (PH_ON(1) && IN(1)) for (int rep_ = 0; rep_ < NREP(1); ++rep_) { if (rep_) xcd_barrier(xbar);
            LAS float* Ls = (LAS float*)lds; LAS float* Lt = Ls + D; int cur_mr = -1;
            f32x4 nx[8];
            { const float* x0 = gw < MX ? p.in[I_X] + (size_t)gw * D : p.in[I_CTX] + (size_t)(gw - MX) * D;
#pragma unroll
              for (int j = 0; j < 8; ++j) nx[j] = *(const f32x4*)(x0 + j * 256 + lane * 4); }
            for (int m = gw; m < MT; m += NGW) {
                const bool isx = m < MX; const int mr = isx ? (m >> 12) : 8;
                if (mr != cur_mr) {
                    const float* sh = modv + (size_t)mr * MODW;
                    __syncthreads();
                    *(LAS f32x4*)(Lt + tid * 4) = *(const f32x4*)(sh + tid * 4); *(LAS f32x4*)(Ls + tid * 4) = *(const f32x4*)(sh + D + tid * 4);
                    __syncthreads();
                    cur_mr = mr;
                }
                bf16_t* o = R0 + (size_t)m * D;
                f32x4 xv[8], sv[8], tv[8];
#pragma unroll
                for (int j = 0; j < 8; ++j) { const int c = j * 256 + lane * 4; xv[j] = nx[j]; sv[j] = *(const LAS f32x4*)(Ls + c); tv[j] = *(const LAS f32x4*)(Lt + c); }
                { const int mn = m + NGW < MT ? m + NGW : m; const float* xn = mn < MX ? p.in[I_X] + (size_t)mn * D : p.in[I_CTX] + (size_t)(mn - MX) * D;
#pragma unroll
                  for (int j = 0; j < 8; ++j) nx[j] = *(const f32x4*)(xn + j * 256 + lane * 4); }
#pragma unroll
                for (int j = 0; j < 8; ++j) { const int c = j * 256 + lane * 4;
                    const f32x4 h = xv[j] * (1.0f + sv[j]) + tv[j]; u32x2 w; w.x = cvt_pk_bf16(h[0], h[1]); w.y = cvt_pk_bf16(h[2], h[3]); *(u32x2*)(o + c) = w; }
            }
        } SEAM(1);
        if (PH_ON(2) && IN(2)) for (int rep_ = 0; rep_ < NREP(2); ++rep_) { if (rep_) xcd_barrier(xbar);
            pg8::Gemm g{R0, (const bf16_t*)(ws + WS_WIA), MT, NWI, D, D}; pg8::StaticOrder S; S.init(MT, NWI, G, bid);
            EpiSwiglu E{(bf16_t*)(ws + WS_R1)};
            pg8::gemm_phase<EpiSwiglu, pg8::StaticOrder>(lds, g, S, E);
        } SEAM(2);
        if (PH_ON(3) && IN(3)) for (int rep_ = 0; rep_ < NREP(3); ++rep_) { if (rep_) xcd_barrier(xbar);
            pg8::Gemm g{(const bf16_t*)(ws + WS_R1), (const bf16_t*)(ws + WS_WOA), MX, D, DFF, DFF}; pg8::StaticOrder S; S.init(MX, D, G, bid);
            EpiResid E{p.in[I_X], p.in[I_CTX], Yx, Yc, nullptr, nullptr, nullptr, modv, 2, 0.5f};
            pg8::gemm_phase<EpiResid, pg8::StaticOrder>(lds, g, S, E);
            pg8::Gemm g2{(const bf16_t*)(ws + WS_R1), (const bf16_t*)(ws + WS_WOA), MC, D, DFF / 4, DFF}; pg8::SplitOrder S2{MC / 256, D / 256, 4, MX / 256, G, bid};
            EpiPartial E2{(float*)(ws + WS_PART)};
            pg8::gemm_phase<EpiPartial, pg8::SplitOrder>(lds, g2, S2, E2);
        } SEAM(3);
        if (PH_ON(4) && IN(4)) for (int rep_ = 0; rep_ < NREP(4); ++rep_) { if (rep_) xcd_barrier(xbar); ln_pass<4>(p, lds, ws, Yx, Yc, modv, lng, lnb, st1, st2, R0, gw, NGW, lane, wave); } SEAM(4);
        if (PH_ON(5) && IN(5)) for (int rep_ = 0; rep_ < NREP(5); ++rep_) { if (rep_) xcd_barrier(xbar);
            pg8::Gemm g{R0, (const bf16_t*)(ws + WS_WIN), MT, INW, D, D}; pg8::RectOrder S; S.init(MX, INW, MC / 256, RIN / 256, G, bid);
            EpiF16 E{(f16_t*)(ws + WS_R1), INW};
            pg8::gemm_phase<EpiF16, pg8::RectOrder>(lds, g, S, E);
        } SEAM(5);
        if (PH_ON(6) && IN(6)) for (int rep_ = 0; rep_ < NREP(6); ++rep_) { if (rep_) xcd_barrier(xbar);
            const f16_t* P = (const f16_t*)(ws + WS_R1);
            f16_t* RKV = (f16_t*)(ws + WS_R2); bf16_t* AL = (bf16_t*)(ws + WS_ALORA);
            const float* mu = p.in[I_MU];
            for (int m = gw; m < MT; m += NGW) {
                const bool isx = m < MX;
                const f16_t* pr = P + (size_t)m * INW;
                bool okA, okB, okC = false, okD = false; long dA, dB, dC = 0, dD = 0;
                if (isx) { const int t = m & 4095, gr = t >> 6, gc = t & 63; okA = gc > 0; okB = gc < 63; okC = gr > 0; okD = gr < 63; dA = -1; dB = 1; dC = -64; dD = 64; }
                else { const int t = (m - MX) & 255; okA = t > 0; okB = t < 255; dA = -1; dB = 1; }
                const f16_t* pA = okA ? pr + dA * INW : pr; const f16_t* pB = okB ? pr + dB * INW : pr;
                const f16_t* pC = okC ? pr + dC * INW : pr; const f16_t* pD = okD ? pr + dD * INW : pr;
                const u32x4 z = (u32x4){0u, 0u, 0u, 0u};
                for (int base = 0; base < 7; base += 4) {
                    u32x4 own[4], vA[4], vB[4], vC[4], vD[4]; f32x4 mu0a[4], mu1a[4];
#pragma unroll
                    for (int u = 0; u < 4; ++u) { int ci = lane + 64 * (base + u); ci = ci < RIN / 8 ? ci : RIN / 8 - 1; const int c = ci * 8;
                        own[u] = *(const u32x4*)(pr + c); vA[u] = *(const u32x4*)(pA + c); vB[u] = *(const u32x4*)(pB + c); vC[u] = *(const u32x4*)(pC + c); vD[u] = *(const u32x4*)(pD + c);
                        mu0a[u] = *(const f32x4*)(mu + c); mu1a[u] = *(const f32x4*)(mu + c + 4); }
#pragma unroll
                    for (int u = 0; u < 4; ++u) {
                        const int ci = lane + 64 * (base + u); const int c = ci * 8;
                        if (ci < RIN / 8) {
                            float fo[8], fA[8], fB[8], fC[8], fD[8], xs[8];
                            h8_to_f(own[u], fo); h8_to_f(okA ? vA[u] : z, fA); h8_to_f(okB ? vB[u] : z, fB); h8_to_f(okC ? vC[u] : z, fC); h8_to_f(okD ? vD[u] : z, fD);
                            const f32x4 mu0 = mu0a[u], mu1 = mu1a[u];
#pragma unroll
                            for (int j = 0; j < 8; ++j) {
                                float sh;
                                if (isx) sh = (j & 3) == 0 ? fA[j] : (j & 3) == 1 ? fB[j] : (j & 3) == 2 ? fC[j] : fD[j];
                                else sh = (j & 1) == 0 ? fA[j] : fB[j];
                                const float mj = j < 4 ? mu0[j] : mu1[j - 4];
                                xs[j] = fo[j] + (sh - fo[j]) * mj;
                            }
                            if (c < 3 * RW) {
                                u32x4 w; w.x = pk_f16(xs[0], xs[1]); w.y = pk_f16(xs[2], xs[3]); w.z = pk_f16(xs[4], xs[5]); w.w = pk_f16(xs[6], xs[7]);
                                *(u32x4*)(RKV + (size_t)m * 3072 + c) = w;
                            } else {
                                const int cl = c - 3 * RW;
#pragma unroll
                                for (int j = 0; j < 8; ++j) { if (cl < 64) xs[j] = tanh_f(xs[j]); else if (cl >= 128) xs[j] = sigm(xs[j]); }
                                u32x4 w; w.x = cvt_pk_bf16(xs[0], xs[1]); w.y = cvt_pk_bf16(xs[2], xs[3]); w.z = cvt_pk_bf16(xs[4], xs[5]); w.w = cvt_pk_bf16(xs[6], xs[7]);
                                *(u32x4*)(AL + (size_t)m * 256 + cl) = w;
                            }
                        }
                    }
                }
            }
            {
                bf16_t* VT = (bf16_t*)(ws + WS_VT);
                const float* gg = p.in[I_GMG]; const float* gb = p.in[I_GMB];
                for (int tk = gw; tk < NB * 32 * 2 * 16; tk += NGW) {
                    const int g = tk & 15, hh = (tk >> 4) & 1, bn = tk >> 5;
                    const int q = hh * 64 + lane; const size_t m = (size_t)bn * 128 + q;
                    const f16_t* src = P + m * INW + RIN + RW + g * 64;
                    float v[64]; float s = 0.f;
#pragma unroll
                    for (int i = 0; i < 8; ++i) { float f[8]; h8_to_f(*(const u32x4*)(src + i * 8), f);
#pragma unroll
                        for (int j = 0; j < 8; ++j) { v[i * 8 + j] = gelu_t(f[j]); s += v[i * 8 + j]; } }
                    const float mean = s * (1.0f / 64.0f); float s2 = 0.f;
#pragma unroll
                    for (int d = 0; d < 64; ++d) { v[d] -= mean; s2 += v[d] * v[d]; }
                    const float rstd = 1.0f / sqrtf(s2 * (1.0f / 64.0f) + LN_EPS);
                    bf16_t* dst = VT + ((size_t)bn * 16 + g) * 64 * 128 + q;
#pragma unroll
                    for (int d = 0; d < 64; ++d) { const float o = v[d] * rstd * gg[g * 64 + d] + gb[g * 64 + d]; dst[d * 128] = (bf16_t)(cvt_pk_bf16(o, 0.f) & 0xffffu); }
                }
            }
        } SEAM(6);
        if (PH_ON(7) && IN(7)) for (int rep_ = 0; rep_ < NREP(7); ++rep_) { if (rep_) xcd_barrier(xbar);
            const f16_t* P = (const f16_t*)(ws + WS_R1);
            const bf16_t* VT = (const bf16_t*)(ws + WS_VT); const bf16_t* WSB = (const bf16_t*)(ws + WS_WSB);
            const float* bs = p.in[I_GMBS];
            const int fr = lane & 15, fq = lane >> 4;
            for (int tk = gw; tk < NB * 32 * 16; tk += NGW) {
                const int g = tk & 15, bn = tk >> 4;
                const bf16_t* vb = VT + ((size_t)bn * 16 + g) * 64 * 128;
                const bf16_t* wb = WSB + (size_t)g * 128 * 128;
                bf16x8 vf[4][4];
#pragma unroll
                for (int nt = 0; nt < 4; ++nt)
#pragma unroll
                    for (int kk = 0; kk < 4; ++kk) vf[nt][kk] = *(const bf16x8*)(vb + (nt * 16 + fr) * 128 + kk * 32 + fq * 8);
                bf16x8 wfn[4]; u32x2 un[4]; float bsn;
#define P7_LOAD(mt_) do { const int pt_ = (mt_) * 16 + fr; const size_t m_ = (size_t)bn * 128 + pt_; \
                    _Pragma("unroll") for (int kk = 0; kk < 4; ++kk) wfn[kk] = *(const bf16x8*)(wb + pt_ * 128 + kk * 32 + fq * 8); \
                    _Pragma("unroll") for (int nt = 0; nt < 4; ++nt) un[nt] = *(const u32x2*)(P + m_ * INW + RIN + g * 64 + nt * 16 + fq * 4); \
                    bsn = bs[g * 128 + pt_]; } while (0)
                P7_LOAD(0);
#pragma unroll 2
                for (int mt = 0; mt < 8; ++mt) {
                    bf16x8 wf[4]; u32x2 uc[4]; const float bsv = bsn;
#pragma unroll
                    for (int kk = 0; kk < 4; ++kk) { wf[kk] = wfn[kk]; uc[kk] = un[kk]; }
                    { const int mtn = mt < 7 ? mt + 1 : 7; P7_LOAD(mtn); }
                    f32x4 acc[4];
#pragma unroll
                    for (int nt = 0; nt < 4; ++nt) { acc[nt] = (f32x4){0.f, 0.f, 0.f, 0.f};
#pragma unroll
                        for (int kk = 0; kk < 4; ++kk) acc[nt] = __builtin_amdgcn_mfma_f32_16x16x32_bf16(vf[nt][kk], wf[kk], acc[nt], 0, 0, 0); }
                    const int pt = mt * 16 + fr; const size_t m = (size_t)bn * 128 + pt;
#pragma unroll
                    for (int nt = 0; nt < 4; ++nt) {
                        const int d0 = nt * 16 + fq * 4;
                        const h16x4 uh = __builtin_bit_cast(h16x4, uc[nt]);
                        float o[4];
#pragma unroll
                        for (int j = 0; j < 4; ++j) o[j] = gelu_t((float)uh[j]) * (acc[nt][j] + bsv);
                        u32x2 w; w.x = cvt_pk_bf16(o[0], o[1]); w.y = cvt_pk_bf16(o[2], o[3]);
                        *(u32x2*)(R0 + m * D + RW + g * 64 + d0) = w;
                    }
                }
#undef P7_LOAD
            }
        } SEAM(7);
        if (PH_ON(8) && IN(8)) for (int rep_ = 0; rep_ < NREP(8); ++rep_) { if (rep_) xcd_barrier(xbar);
            pg8::Gemm g{(const bf16_t*)(ws + WS_ALORA), (const bf16_t*)(ws + WS_LORAB), MT, NLORA, KLORA / 2, KLORA}; pg8::LoraOrder S; S.so.init(MT, NLORA, G, bid);
            EpiLora E{(f16_t*)(ws + WS_R1), (const float*)(ws + WS_LBIAS)};
            pg8::gemm_phase<EpiLora, pg8::LoraOrder>(lds, g, S, E);
        } SEAM(8);
        if (PH_ON(9) && IN(9)) for (int rep_ = 0; rep_ < NREP(9); ++rep_) { if (rep_) xcd_barrier(xbar);
            const f16_t* RKV = (const f16_t*)(ws + WS_R2); const f16_t* L = (const f16_t*)(ws + WS_R1);
            f16_t* YSC = (f16_t*)(ws + WS_YSC);
            constexpr int TC = 32, NCH = (CTXL + SEQ) / TC, NSUB = 2 * NCH, LD64 = 72, LD32 = 40;
            constexpr int RS = 68, AS = 32 * RS;
            LAS float* raw = (LAS float*)lds;
            LAS float* ybuf = (LAS float*)(lds + 52224);
            LAS float* AabT = (LAS float*)(lds + 120320);
            LAS float* ScT = (LAS float*)(lds + 121344);
            LAS float* ScT2 = (LAS float*)(lds + 121600);
            LAS float* ScM = (LAS float*)(lds + 121856);
            LAS bf16_t* XTa = (LAS bf16_t*)(lds + 122112);
            LAS bf16_t* UTa = (LAS bf16_t*)(lds + 127232);
            LAS bf16_t* SB = (LAS bf16_t*)(lds + 132352);
#define D64(pb_, q_) ((LAS bf16_t*)(lds + 60416 + (pb_) * 9216 + (q_) * 2304))
#define D32(pb_, q_) ((LAS bf16_t*)(lds + 78848 + (pb_) * 15360 + (q_) * 5120))
#define P16B(pb_) ((LAS float*)(lds + 109568 + (pb_) * 256))
#define AMB(pb_, q_) ((LAS bf16_t*)(lds + 110080 + (pb_) * 5120 + (q_) * 1280))
            const int fr = lane & 15, fq = lane >> 4;
#define FRAG(M_, ld_, rb_, kk_) (*(const LAS bf16x8*)((M_) + ((rb_) + fr) * (ld_) + (kk_) * 32 + fq * 8))
#define LDSFENCE() asm volatile("s_waitcnt lgkmcnt(0)" ::: "memory")
            for (int sid = bid; sid < NB * NH * 2; sid += G) {
                const int dir = sid & 1, h = (sid >> 1) & 15, b = sid >> 5;
                const int ps = tid >> 4, kg = tid & 15, ch = h * 64 + 4 * kg;
                const f32x4 kkp = *(const f32x4*)(p.in[I_KK] + ch), kap = *(const f32x4*)(p.in[I_KA] + ch);
                const f16_t* Le = L + (size_t)dir * MT * RW; const f16_t* Li = L + (size_t)(2 + dir) * MT * RW;
                for (int i = tid; i < (141568 - 60416) / 4; i += 512) ((LAS unsigned*)(lds + 60416))[i] = 0u;
                f32x4 accS[4], accY = (f32x4){0.f, 0.f, 0.f, 0.f};
#pragma unroll
                for (int q = 0; q < 4; ++q) accS[q] = (f32x4){0.f, 0.f, 0.f, 0.f};
                u32x2 pr_, pk_, pv_, pi_, pe_;
#define TOKROW(c_) (((c_) * TC + ps) < CTXL ? (MX + b * CTXL + (dir ? (CTXL - 1 - ((c_) * TC + ps)) : ((c_) * TC + ps))) : (b * SEQ + (dir ? (SEQ - 1 - ((c_) * TC + ps - CTXL)) : ((c_) * TC + ps - CTXL))))
#define PREFETCH(c_) do { const int mr_ = TOKROW(c_); const f16_t* q_ = RKV + (size_t)mr_ * 3072 + ch; \
                    pr_ = *(const u32x2*)q_; pk_ = *(const u32x2*)(q_ + RW); pv_ = *(const u32x2*)(q_ + 2 * RW); \
                    pi_ = *(const u32x2*)(Li + (size_t)mr_ * RW + ch); pe_ = *(const u32x2*)(Le + (size_t)mr_ * RW + ch); } while (0)
#define PREPROC() do {   \
                    const h16x4 hr = __builtin_bit_cast(h16x4, pr_), hk = __builtin_bit_cast(h16x4, pk_), hv = __builtin_bit_cast(h16x4, pv_), hi = __builtin_bit_cast(h16x4, pi_), he = __builtin_bit_cast(h16x4, pe_); \
                    f32x4 k4, kk4, ic4, e4, r4, v4; \
                    _Pragma("unroll") for (int j_ = 0; j_ < 4; ++j_) { k4[j_] = (float)hk[j_]; ic4[j_] = (float)hi[j_]; r4[j_] = (float)hr[j_]; v4[j_] = (float)hv[j_]; e4[j_] = (float)he[j_]; } \
                    kk4 = k4 * kkp; \
                    float ss = (kk4[0] * kk4[0] + kk4[1] * kk4[1]) + (kk4[2] * kk4[2] + kk4[3] * kk4[3]); \
                    ss += dpp_f<DPP_XOR1>(ss); ss += dpp_f<DPP_XOR2>(ss); ss += dpp_f<DPP_HALF_MIRROR>(ss); ss += dpp_f<DPP_MIRROR>(ss); \
                    const float inv = __builtin_amdgcn_rsqf(fmaxf(ss, 1e-24f));        \
                    kk4 = kk4 * inv; \
                    const f32x4 kd4 = k4 * (1.0f + (ic4 - 1.0f) * kap), bb4 = kk4 * ic4; \
                    const int o_ = ps * RS + 4 * kg; \
                    *(LAS f32x4*)(raw + 0 * AS + o_) = e4; *(LAS f32x4*)(raw + 1 * AS + o_) = kk4; *(LAS f32x4*)(raw + 2 * AS + o_) = bb4; \
                    *(LAS f32x4*)(raw + 3 * AS + o_) = kd4; *(LAS f32x4*)(raw + 4 * AS + o_) = r4; *(LAS f32x4*)(raw + 5 * AS + o_) = v4; } while (0)
#define FLUSH(c_) do { const f32x4 y4 = *(const LAS f32x4*)(ybuf + ps * 64 + 4 * kg); u32x2 w_; w_.x = pk_f16(y4[0], y4[1]); w_.y = pk_f16(y4[2], y4[3]); \
                    *(u32x2*)(YSC + (size_t)dir * MX * RW + (size_t)TOKROW(c_) * RW + ch) = w_; } while (0)
                PREFETCH(0);
                PREPROC();
                PREFETCH(1);
                __syncthreads();
                for (int j = -1; j < NSUB; ++j) {
                    const int pb = j & 1, s0 = (j & 1) * 16;
                    if (wave < 4) {
                        if (j >= 0) {
                            f32x4 accX = (f32x4){0.f, 0.f, 0.f, 0.f}; accY = accX;
#pragma unroll
                            for (int kk = 0; kk < 2; ++kk) { const bf16x8 bS = FRAG(SB, LD64, wave * 16, kk);
                                accX = __builtin_amdgcn_mfma_f32_16x16x32_bf16(FRAG(D64(pb, 0), LD64, 0, kk), bS, accX, 0, 0, 0);
                                accY = __builtin_amdgcn_mfma_f32_16x16x32_bf16(bS, FRAG(D64(pb, 1), LD64, 0, kk), accY, 0, 0, 0); }
                            const bf16x8 vB = FRAG(D32(pb, 2), LD32, wave * 16, 0);
                            accX = __builtin_amdgcn_mfma_f32_16x16x32_bf16(FRAG(AMB(pb, 0), LD32, 0, 0), vB, accX, 0, 0, 0);
                            accY = __builtin_amdgcn_mfma_f32_16x16x32_bf16(vB, FRAG(AMB(pb, 1), LD32, 0, 0), accY, 0, 0, 0);
                            { u32x2 w_; w_.x = cvt_pk_bf16(accX[0], accX[1]); w_.y = cvt_pk_bf16(accX[2], accX[3]); *(LAS u32x2*)(XTa + (wave * 16 + fr) * LD32 + fq * 4) = w_; }
                            LDSFENCE();
                            const bf16x8 xB = FRAG(XTa, LD32, wave * 16, 0);
                            const f32x4 accU = __builtin_amdgcn_mfma_f32_16x16x32_bf16(FRAG(AMB(pb, 3), LD32, 0, 0), xB, (f32x4){0.f, 0.f, 0.f, 0.f}, 0, 0, 0);
                            { u32x2 w_; w_.x = cvt_pk_bf16(accU[0], accU[1]); w_.y = cvt_pk_bf16(accU[2], accU[3]); *(LAS u32x2*)(UTa + (wave * 16 + fr) * LD32 + fq * 4) = w_; }
                        }
                    } else if (j + 1 < NSUB) {
                        const int pbn = (j + 1) & 1, s0n = ((j + 1) & 1) * 16, tp = tid - 256, t = tp & 15, k0 = 4 * (tp >> 4);
                        const int ro = (s0n + t) * RS + k0;
                        const f32x4 e4 = *(const LAS f32x4*)(raw + ro), kk4 = *(const LAS f32x4*)(raw + AS + ro), bb4 = *(const LAS f32x4*)(raw + 2 * AS + ro), kd4 = *(const LAS f32x4*)(raw + 3 * AS + ro), r4 = *(const LAS f32x4*)(raw + 4 * AS + ro), v4 = *(const LAS f32x4*)(raw + 5 * AS + ro);
                        f32x4 Pt, Pp, iP, PC;
#pragma unroll
                        for (int q = 0; q < 4; ++q) { float x = e4[q];
                            x += dpp_fz<0x111>(x); x += dpp_fz<0x112>(x); x += dpp_fz<0x114>(x); x += dpp_fz<0x118>(x);
                            const float pt = __expf(-x), sh = dpp_fz<0x111>(pt);
                            Pt[q] = pt; Pp[q] = (t == 0) ? 1.0f : sh; iP[q] = __builtin_amdgcn_rcpf(pt); PC[q] = iP[q] * __shfl(pt, lane | 15); }
                        { u32x2 w_;
                          w_.x = cvt_pk_bf16(-kk4[0] * Pp[0], -kk4[1] * Pp[1]); w_.y = cvt_pk_bf16(-kk4[2] * Pp[2], -kk4[3] * Pp[3]); *(LAS u32x2*)(D64(pbn, 0) + t * LD64 + k0) = w_;
                          w_.x = cvt_pk_bf16(r4[0] * Pt[0], r4[1] * Pt[1]); w_.y = cvt_pk_bf16(r4[2] * Pt[2], r4[3] * Pt[3]); *(LAS u32x2*)(D64(pbn, 1) + t * LD64 + k0) = w_;
                          w_.x = cvt_pk_bf16(bb4[0] * iP[0], bb4[1] * iP[1]); w_.y = cvt_pk_bf16(bb4[2] * iP[2], bb4[3] * iP[3]); *(LAS u32x2*)(D64(pbn, 2) + t * LD64 + k0) = w_;
                          w_.x = cvt_pk_bf16(kd4[0] * iP[0], kd4[1] * iP[1]); w_.y = cvt_pk_bf16(kd4[2] * iP[2], kd4[3] * iP[3]); *(LAS u32x2*)(D64(pbn, 3) + t * LD64 + k0) = w_; }
                        {
                            unsigned own[6];
                            own[0] = cvt_pk_bf16(bb4[0] * PC[0], bb4[1] * PC[1]); own[1] = cvt_pk_bf16(bb4[2] * PC[2], bb4[3] * PC[3]);
                            own[2] = cvt_pk_bf16(kd4[0] * PC[0], kd4[1] * PC[1]); own[3] = cvt_pk_bf16(kd4[2] * PC[2], kd4[3] * PC[3]);
                            own[4] = cvt_pk_bf16(v4[0], v4[1]); own[5] = cvt_pk_bf16(v4[2], v4[3]);
                            const bool ev = (t & 1) == 0;
#pragma unroll
                            for (int q = 0; q < 6; ++q) { const unsigned pt = dpp_u<DPP_XOR1>(own[q]);
                                const unsigned val = ev ? ((own[q] & 0xffffu) | (pt << 16)) : ((pt >> 16) | (own[q] & 0xffff0000u));
                                const int row = k0 + 2 * (q & 1) + (ev ? 0 : 1), col = ev ? t : t - 1;
                                *(LAS unsigned*)(D32(pbn, q >> 1) + row * LD32 + col) = val; }
                        }
                        if (t == 15) *(LAS f32x4*)(P16B(pbn) + k0) = Pt;
                    }
                    if (j >= 2 && (j & 1) == 0 && (j >> 1) - 1 >= CTXL / TC) FLUSH((j >> 1) - 1);
                    __syncthreads();
                    if (wave < 4) {
                        if (j >= 0) {
                            const bf16x8 uB = FRAG(UTa, LD32, wave * 16, 0);
                            accY = __builtin_amdgcn_mfma_f32_16x16x32_bf16(uB, FRAG(AMB(pb, 2), LD32, 0, 0), accY, 0, 0, 0);
                            *(LAS f32x4*)(ybuf + (s0 + fr) * 64 + wave * 16 + fq * 4) = accY;
                            const bf16x8 vA = FRAG(D32(pb, 2), LD32, wave * 16, 0);
#pragma unroll
                            for (int kt = 0; kt < 4; ++kt) {
                                const f32x4 p16 = *(const LAS f32x4*)(P16B(pb) + kt * 16 + fq * 4);
                                accS[kt] = accS[kt] * p16;
                                accS[kt] = __builtin_amdgcn_mfma_f32_16x16x32_bf16(FRAG(D32(pb, 1), LD32, kt * 16, 0), vA, accS[kt], 0, 0, 0);
                                accS[kt] = __builtin_amdgcn_mfma_f32_16x16x32_bf16(FRAG(D32(pb, 0), LD32, kt * 16, 0), uB, accS[kt], 0, 0, 0);
                                u32x2 w_; w_.x = cvt_pk_bf16(accS[kt][0], accS[kt][1]); w_.y = cvt_pk_bf16(accS[kt][2], accS[kt][3]);
                                *(LAS u32x2*)(SB + (wave * 16 + fr) * LD64 + kt * 16 + fq * 4) = w_;
                            }
                        }
                    } else if (j + 1 < NSUB) {
                        const int pbn = (j + 1) & 1, which = wave - 4;
                        const LAS bf16_t* Am = D64(pbn, which < 2 ? 0 : 1); const LAS bf16_t* Bm = D64(pbn, (which & 1) ? 2 : 3);
                        f32x4 a = (f32x4){0.f, 0.f, 0.f, 0.f};
#pragma unroll
                        for (int kk = 0; kk < 2; ++kk) a = __builtin_amdgcn_mfma_f32_16x16x32_bf16(FRAG(Am, LD64, 0, kk), FRAG(Bm, LD64, 0, kk), a, 0, 0, 0);
#pragma unroll
                        for (int rg = 0; rg < 4; ++rg) { const int t = fq * 4 + rg; const bool keep = which < 2 ? (t > fr) : (t >= fr); a[rg] = keep ? a[rg] : 0.f; }
                        if (which != 1) {
                            LAS bf16_t* dst = AMB(pbn, which == 0 ? 0 : (which == 2 ? 1 : 2));
#pragma unroll
                            for (int rg = 0; rg < 4; ++rg) { const float nbv = dpp_f<DPP_XOR1>(a[rg]);
                                if ((fr & 1) == 0) *(LAS unsigned*)(dst + (fq * 4 + rg) * LD32 + fr) = cvt_pk_bf16(a[rg], nbv); }
                        } else {
                            *(LAS f32x4*)(AabT + fr * 16 + fq * 4) = a;
                            LDSFENCE();
                            const int g = (lane >> 3) & 3, c = lane & 7, o = (g == 1 || g == 2) ? 8 : 0;
                            float U[8];
                            { const f32x4 h0 = *(const LAS f32x4*)(AabT + c * 16 + 8), h1 = *(const LAS f32x4*)(AabT + c * 16 + 12);
#pragma unroll
                              for (int r = 0; r < 8; ++r) { const float rh = r < 4 ? h0[r] : h1[r - 4]; U[r] = (g == 2) ? rh : ((r == c) ? 1.0f : 0.0f); } }
#pragma unroll
                            for (int i = 0; i < 7; ++i) {
                                const LAS float* colp = AabT + (o + i) * 16 + o;
                                const f32x4 c0 = *(const LAS f32x4*)colp, c1 = *(const LAS f32x4*)(colp + 4);
#pragma unroll
                                for (int r = i + 1; r < 8; ++r) U[r] += (r < 4 ? c0[r] : c1[r - 4]) * U[i];
                            }
                            if (lane < 24) { LAS float* sc = (g == 0 ? ScT : (g == 1 ? ScT2 : ScM)) + c * 8;
                                *(LAS f32x4*)sc = (f32x4){U[0], U[1], U[2], U[3]}; *(LAS f32x4*)(sc + 4) = (f32x4){U[4], U[5], U[6], U[7]}; }
                            LDSFENCE();
                            const int r21 = lane >> 3;
                            const float t11 = ScT[c * 8 + r21], t22 = ScT2[c * 8 + r21];
                            float t21 = 0.f;
                            { const f32x4 t0 = *(const LAS f32x4*)(ScT + c * 8), t1 = *(const LAS f32x4*)(ScT + c * 8 + 4);
#pragma unroll
                              for (int i = 0; i < 8; ++i) t21 += ScM[i * 8 + r21] * (i < 4 ? t0[i] : t1[i - 4]); }
                            LAS bf16_t* dst = AMB(pbn, 3);
                            const float n11 = dpp_f<DPP_XOR1>(t11), n22 = dpp_f<DPP_XOR1>(t22), n21 = dpp_f<DPP_XOR1>(t21);
                            if ((lane & 1) == 0) {
                                *(LAS unsigned*)(dst + r21 * LD32 + c) = cvt_pk_bf16(t11, n11);
                                *(LAS unsigned*)(dst + (8 + r21) * LD32 + 8 + c) = cvt_pk_bf16(t22, n22);
                                *(LAS unsigned*)(dst + (8 + r21) * LD32 + c) = cvt_pk_bf16(t21, n21);
                            }
                        }
                    }
                    if (j >= 0 && (j & 1) == 0 && (j >> 1) + 1 < NCH) { PREPROC(); if ((j >> 1) + 2 < NCH) PREFETCH((j >> 1) + 2); }
                    __syncthreads();
                }
                FLUSH(NCH - 1);
                __syncthreads();
            }
#undef FRAG
#undef LDSFENCE
#undef TOKROW
#undef PREFETCH
#undef PREPROC
#undef FLUSH
#undef D64
#undef D32
#undef P16B
#undef AMB
        } SEAM(9);

        if (PH_ON(10) && IN(10)) for (int rep_ = 0; rep_ < NREP(10); ++rep_) { if (rep_) xcd_barrier(xbar);
            const f16_t* RKV = (const f16_t*)(ws + WS_R2); const f16_t* L = (const f16_t*)(ws + WS_R1); const f16_t* YSC = (const f16_t*)(ws + WS_YSC);
            const int ch0 = lane * 16;
            LAS float* Lka = (LAS float*)lds; LAS float* Lrk = Lka + RW; LAS float* Lgg = Lrk + RW; LAS float* Lgb = Lgg + RW;
            for (int i = tid; i < RW; i += 512) { Lka[i] = p.in[I_KA][i]; Lrk[i] = p.in[I_RK][i]; Lgg[i] = p.in[I_GNG][i]; Lgb[i] = p.in[I_GNB][i]; }
            __syncthreads();
            u32x4 nr[16];
#define P10_LOAD(m_) do { const size_t mm_ = (size_t)(m_); \
                const f16_t* a0_ = YSC + mm_ * RW + ch0; const f16_t* a1_ = YSC + (size_t)MX * RW + mm_ * RW + ch0; const f16_t* a2_ = RKV + mm_ * 3072 + ch0; \
                const f16_t* a3_ = L + (size_t)2 * MT * RW + mm_ * RW + ch0; const f16_t* a4_ = L + (size_t)3 * MT * RW + mm_ * RW + ch0; const f16_t* a5_ = L + (size_t)4 * MT * RW + mm_ * RW + ch0; \
                nr[0] = *(const u32x4*)a0_; nr[1] = *(const u32x4*)(a0_ + 8); nr[2] = *(const u32x4*)a1_; nr[3] = *(const u32x4*)(a1_ + 8); \
                nr[4] = *(const u32x4*)a2_; nr[5] = *(const u32x4*)(a2_ + 8); nr[6] = *(const u32x4*)(a2_ + RW); nr[7] = *(const u32x4*)(a2_ + RW + 8); nr[8] = *(const u32x4*)(a2_ + 2 * RW); nr[9] = *(const u32x4*)(a2_ + 2 * RW + 8); \
                nr[10] = *(const u32x4*)a3_; nr[11] = *(const u32x4*)(a3_ + 8); nr[12] = *(const u32x4*)a4_; nr[13] = *(const u32x4*)(a4_ + 8); nr[14] = *(const u32x4*)a5_; nr[15] = *(const u32x4*)(a5_ + 8); } while (0)
            if (gw < MX) P10_LOAD(gw);
            for (int m = gw; m < MX; m += NGW) {
                float y[16], r[16], k[16], v[16], i0[16], i1[16], gt[16], t[8];
#define CV16(dst, q_) do { h8_to_f(nr[q_], t); _Pragma("unroll") for (int j = 0; j < 8; ++j) dst[j] = t[j]; h8_to_f(nr[(q_) + 1], t); _Pragma("unroll") for (int j = 0; j < 8; ++j) dst[8 + j] = t[j]; } while (0)
                CV16(y, 0); CV16(r, 2);
#pragma unroll
                for (int j = 0; j < 16; ++j) y[j] += r[j];
                CV16(r, 4); CV16(k, 6); CV16(v, 8); CV16(i0, 10); CV16(i1, 12); CV16(gt, 14);
#undef CV16
                { const int mn = m + NGW < MX ? m + NGW : m; P10_LOAD(mn); }
                float s = 0.f, bon = 0.f;
#pragma unroll
                for (int j4 = 0; j4 < 16; j4 += 4) { const f32x4 ka4 = *(const LAS f32x4*)(Lka + ch0 + j4), rk4 = *(const LAS f32x4*)(Lrk + ch0 + j4);
#pragma unroll
                    for (int jj = 0; jj < 4; ++jj) { const int j = j4 + jj; s += y[j]; const float kd = k[j] * (2.0f + (i0[j] + i1[j] - 2.0f) * ka4[jj]); bon += r[j] * kd * rk4[jj]; } }
                s += dpp_f<DPP_XOR1>(s); s += dpp_f<DPP_XOR2>(s); bon += dpp_f<DPP_XOR1>(bon); bon += dpp_f<DPP_XOR2>(bon);
                const float mean = s * (1.0f / 64.0f); float s2 = 0.f;
#pragma unroll
                for (int j = 0; j < 16; ++j) { y[j] -= mean; s2 += y[j] * y[j]; }
                s2 += dpp_f<DPP_XOR1>(s2); s2 += dpp_f<DPP_XOR2>(s2);
                const float rstd = 1.0f / sqrtf(s2 * (1.0f / 64.0f) + GN_EPS);
                unsigned w[8];
#pragma unroll
                for (int j4 = 0; j4 < 16; j4 += 4) { const f32x4 gg4 = *(const LAS f32x4*)(Lgg + ch0 + j4), gb4 = *(const LAS f32x4*)(Lgb + ch0 + j4);
#pragma unroll
                    for (int jj = 0; jj < 4; jj += 2) { const int j = j4 + jj;
                        const float o0 = (y[j] * rstd * gg4[jj] + gb4[jj] + bon * v[j]) * gt[j], o1 = (y[j + 1] * rstd * gg4[jj + 1] + gb4[jj + 1] + bon * v[j + 1]) * gt[j + 1]; w[j >> 1] = cvt_pk_bf16(o0, o1); } }
                bf16_t* o = R0 + (size_t)m * D + ch0;
                *(u32x4*)o = (u32x4){w[0], w[1], w[2], w[3]}; *(u32x4*)(o + 8) = (u32x4){w[4], w[5], w[6], w[7]};
            }
#undef P10_LOAD
        } SEAM(10);
        if (PH_ON(11) && IN(11)) for (int rep_ = 0; rep_ < NREP(11); ++rep_) { if (rep_) xcd_barrier(xbar);
            pg8::Gemm g{R0, (const bf16_t*)(ws + WS_WOUT), MX, D, D, D}; pg8::StaticOrder S; S.init(MX, D, G, bid);
            EpiResid E{Yx, Yc, Yx, Yc, st1, lng, lnb, modv, 5, 1.0f};
            pg8::gemm_phase<EpiResid, pg8::StaticOrder>(lds, g, S, E);
        } SEAM(11);
        if (PH_ON(12) && IN(12)) for (int rep_ = 0; rep_ < NREP(12); ++rep_) { if (rep_) xcd_barrier(xbar); ln_pass<12>(p, lds, ws, Yx, Yc, modv, lng, lnb, st1, st2, R0, gw, NGW, lane, wave); } SEAM(12);
        if (PH_ON(13) && IN(13)) for (int rep_ = 0; rep_ < NREP(13); ++rep_) { if (rep_) xcd_barrier(xbar);
            pg8::Gemm g{R0, (const bf16_t*)(ws + WS_WIB), MX, NWI, D, D}; pg8::StaticOrder S; S.init(MX, NWI, G, bid);
            EpiSwiglu E{(bf16_t*)(ws + WS_R1)};
            pg8::gemm_phase<EpiSwiglu, pg8::StaticOrder>(lds, g, S, E);
        } SEAM(13);
        if (PH_ON(14) && IN(14)) for (int rep_ = 0; rep_ < NREP(14); ++rep_) { if (rep_) xcd_barrier(xbar);
            pg8::Gemm g{(const bf16_t*)(ws + WS_R1), (const bf16_t*)(ws + WS_WOB), MX, D, DFF, DFF}; pg8::StaticOrder S; S.init(MX, D, G, bid);
            EpiResid E{Yx, Yc, Yx, Yc, st2, lng + D, lnb + D, modv, 8, 0.5f};
            pg8::gemm_phase<EpiResid, pg8::StaticOrder>(lds, g, S, E);
        } SEAM(14);
        if (PH_ON(15) && IN(15)) for (int rep_ = 0; rep_ < NREP(15); ++rep_) { if (rep_) xcd_barrier(xbar);
            const float* lg = lng + 2 * D; const float* lb = lnb + 2 * D;
            LAS float* Lg = (LAS float*)lds; LAS float* Lb = Lg + D;
            *(LAS f32x4*)(Lg + tid * 4) = *(const f32x4*)(lg + tid * 4); *(LAS f32x4*)(Lb + tid * 4) = *(const f32x4*)(lb + tid * 4);
            __syncthreads();
            f32x4 nv[8];
#pragma unroll
            for (int q = 0; q < 8; ++q) nv[q] = *(const f32x4*)(Yx + (size_t)gw * D + q * 256 + lane * 4);
            for (int m = gw; m < MX; m += NGW) {
                float* yr = Yx + (size_t)m * D;
                f32x4 v[8]; float s = 0.f;
#pragma unroll
                for (int q = 0; q < 8; ++q) { v[q] = nv[q]; s += (v[q][0] + v[q][1]) + (v[q][2] + v[q][3]); }
                { const int mn = m + NGW < MX ? m + NGW : m;
#pragma unroll
                  for (int q = 0; q < 8; ++q) nv[q] = *(const f32x4*)(Yx + (size_t)mn * D + q * 256 + lane * 4); }
                const float mean = wave_sum(s) * (1.0f / D); float s2 = 0.f;
#pragma unroll
                for (int q = 0; q < 8; ++q) { v[q] = v[q] - mean; s2 += (v[q][0] * v[q][0] + v[q][1] * v[q][1]) + (v[q][2] * v[q][2] + v[q][3] * v[q][3]); }
                const float rstd = 1.0f / sqrtf(wave_sum(s2) * (1.0f / D) + LN_EPS);
                f32x4 g8[8], b8[8];
#pragma unroll
                for (int q = 0; q < 8; ++q) { const int c = q * 256 + lane * 4; g8[q] = *(const LAS f32x4*)(Lg + c); b8[q] = *(const LAS f32x4*)(Lb + c); }
#pragma unroll
                for (int q = 0; q < 8; ++q) { const int c = q * 256 + lane * 4; *(f32x4*)(yr + c) = v[q] * rstd * g8[q] + b8[q]; }
            }
        } SEAM(15);
#undef IN
#undef SEAM
}

extern "C" void kernel_launch(void* const* d_in, const int* in_sizes, int n_in, void* d_out, int out_size, void* d_ws, size_t ws_size, hipStream_t stream) {
    static int grid = 0;
    if (grid == 0) {
        int dev = 0, cus = 0, per_cu = 0;
        hipGetDevice(&dev);
        hipDeviceGetAttribute(&cus, hipDeviceAttributeMultiprocessorCount, dev);
        hipFuncSetAttribute((const void*)fwd_megakernel, hipFuncAttributeMaxDynamicSharedMemorySize, LDS_BYTES);
        hipOccupancyMaxActiveBlocksPerMultiprocessor(&per_cu, (const void*)fwd_megakernel, 512, LDS_BYTES);
        if (per_cu < 1) per_cu = 1;
        grid = cus * per_cu;
        if (ws_size < WS_END) fprintf(stderr, "kernel_launch: workspace too small: %zu < %zu\n", ws_size, (size_t)WS_END);
    }
    (void)hipMemsetAsync(d_ws, 0, 16384, stream);
    Params p{};
    for (int i = 0; i < 29; ++i) p.in[i] = (const float*)d_in[i];
    p.out = (float*)d_out; p.ws = (unsigned char*)d_ws;
#if SPLIT_LAUNCH
    for (int ph = 0; ph < 16; ++ph) {
        p.ph_lo = ph; p.ph_hi = ph + 1;
        hipLaunchKernelGGL(fwd_megakernel, dim3(grid), dim3(512), LDS_BYTES, stream, p);
    }
#else
    p.ph_lo = 0; p.ph_hi = 16;
    void* args[] = {&p};
    hipError_t e = hipLaunchCooperativeKernel((const void*)fwd_megakernel, dim3(grid), dim3(512), args, LDS_BYTES, stream);
    if (e != hipSuccess) fprintf(stderr, "cooperative launch failed: %s (grid %d)\n", hipGetErrorString(e), grid);
#endif
}
```

```cpp
#include <hip/hip_runtime.h>
#include <hip/hip_cooperative_groups.h>
#include <cstdio>
namespace cg = cooperative_groups;

#ifndef SPLIT_LAUNCH
#define SPLIT_LAUNCH 0
#endif

#ifndef PHMASK
#define PHMASK 0xFFFF
#endif
#define PH_ON(n) (((PHMASK) >> (n)) & 1)
#ifndef DUPMASK
#define DUPMASK 0
#endif
#define NREP(n) ((((DUPMASK) >> (n)) & 1) ? 2 : 1)
#define LAS __attribute__((address_space(3)))
typedef unsigned short bf16_t;
typedef unsigned short f16_t;
typedef short bf16x8 __attribute__((ext_vector_type(8)));
typedef float f32x4 __attribute__((ext_vector_type(4)));
typedef float f32x2 __attribute__((ext_vector_type(2)));
typedef unsigned u32x4 __attribute__((ext_vector_type(4)));
typedef unsigned u32x2 __attribute__((ext_vector_type(2)));
typedef _Float16 h16x2 __attribute__((ext_vector_type(2)));
typedef _Float16 h16x4 __attribute__((ext_vector_type(4)));
typedef _Float16 h16x8 __attribute__((ext_vector_type(8)));

constexpr int D = 2048, NB = 8, SEQ = 4096, CTXL = 256;
constexpr int MX = NB * SEQ, MC = NB * CTXL, MT = MX + MC;
constexpr int DFF = 5632, NWI = 2 * DFF, INW = 5376, RIN = 3328, RW = 1024, NH = 16, HD = 64;
constexpr int MODW = 9 * D;
constexpr int NLORA = 5 * RW, KLORA = 256;
constexpr float ALPHA = 1.189207115002721f;
constexpr float LN_EPS = 1e-5f, GN_EPS = 64e-5f;

constexpr size_t MiB = 1u << 20;
constexpr size_t WS_MODV = 1 * MiB;
constexpr size_t WS_ST1 = 2 * MiB;
constexpr size_t WS_ST2 = 2 * MiB + 512 * 1024;
constexpr size_t WS_WSB = 3 * MiB;
constexpr size_t WS_LORAB = 4 * MiB;
constexpr size_t WS_LBIAS = 6 * MiB + 512 * 1024;
constexpr size_t WS_WIN = 7 * MiB;
constexpr size_t WS_WOUT = 28 * MiB;
constexpr size_t WS_WIA = 36 * MiB;
constexpr size_t WS_WOA = 80 * MiB;
constexpr size_t WS_Y1C = 102 * MiB;
constexpr size_t WS_R0 = 118 * MiB;
constexpr size_t WS_R1 = 254 * MiB;
constexpr size_t WS_ALORA = WS_R1 + (size_t)MT * INW * 2;
constexpr size_t WS_R2 = 628 * MiB;
constexpr size_t WS_PART = WS_R2;
constexpr size_t WS_VT = WS_R2 + (size_t)MT * 3072 * 2;
constexpr size_t WS_YSC = WS_VT;
constexpr size_t WS_WIB = WS_R2;
constexpr size_t WS_WOB = WS_R2 + 44 * MiB;
constexpr size_t WS_END = WS_YSC + (size_t)2 * MX * RW * 2;
static_assert(WS_END <= 1024 * MiB, "ws map");
static_assert(WS_R1 + (size_t)MT * DFF * 2 <= WS_R2, "R1");
static_assert(WS_ALORA + (size_t)MT * 256 * 2 <= WS_R2, "alora");

constexpr int LDS_BYTES = 143360;

typedef __bf16 bf16v2 __attribute__((ext_vector_type(2)));
__device__ __forceinline__ unsigned cvt_pk_bf16(float lo, float hi) { const f32x2 v = (f32x2){lo, hi}; const bf16v2 b = __builtin_convertvector(v, bf16v2); return __builtin_bit_cast(unsigned, b); }
__device__ __forceinline__ unsigned pk_f16(float lo, float hi) { h16x2 v; v.x = (_Float16)lo; v.y = (_Float16)hi; return __builtin_bit_cast(unsigned, v); }
__device__ __forceinline__ float sigm(float x) { return __builtin_amdgcn_rcpf(1.0f + __expf(-x)); }
__device__ __forceinline__ float siluf(float x) { return x * sigm(x); }
__device__ __forceinline__ float gelu_t(float x) { return x * sigm(1.5957691216057308f * (x + 0.044715f * x * x * x)); }
__device__ __forceinline__ float tanh_f(float x) { return 2.0f * sigm(2.0f * x) - 1.0f; }
template <int CTRL> __device__ __forceinline__ float dpp_f(float x) {
    return __builtin_bit_cast(float, __builtin_amdgcn_update_dpp(0, __builtin_bit_cast(int, x), CTRL, 0xF, 0xF, false));
}
template <int CTRL> __device__ __forceinline__ float dpp_fz(float x) {
    return __builtin_bit_cast(float, __builtin_amdgcn_update_dpp(0, __builtin_bit_cast(int, x), CTRL, 0xF, 0xF, true));
}
template <int CTRL> __device__ __forceinline__ unsigned dpp_u(unsigned x) {
    return (unsigned)__builtin_amdgcn_update_dpp(0, (int)x, CTRL, 0xF, 0xF, false);
}
constexpr int DPP_XOR1 = 0xB1, DPP_XOR2 = 0x4E, DPP_HALF_MIRROR = 0x141, DPP_MIRROR = 0x140;
__device__ __forceinline__ float wave_sum(float v) {
    v += dpp_f<DPP_XOR1>(v); v += dpp_f<DPP_XOR2>(v); v += dpp_f<DPP_HALF_MIRROR>(v); v += dpp_f<DPP_MIRROR>(v);
    v += __shfl_xor(v, 16); v += __shfl_xor(v, 32);
    return v;
}
__device__ __forceinline__ void h8_to_f(const u32x4 v, float* f) {
    const h16x8 h = __builtin_bit_cast(h16x8, v);
#pragma unroll
    for (int j = 0; j < 8; ++j) f[j] = (float)h[j];
}

namespace pg8 {
constexpr int BM = 256, BK = 64, HALF = 128, HTB = HALF * BK * 2, STAGE_BYTES = 8 * HTB, NXCD = 8, WGM = 8;
__host__ __device__ __forceinline__ int lds_byte(int r, int c) { const int st = (r >> 4) * 2 + (c >> 5), rr = r & 15, cc = c & 31, ob = rr * 64 + cc * 2; return st * 1024 + (ob ^ (((ob >> 9) & 1) << 5)); }
__host__ __device__ __forceinline__ void stage_rc(int b, int& R, int& C) { const int st = b / 1024, sb = b % 1024, swz = sb ^ (((sb >> 9) & 1) << 5); R = (st >> 1) * 16 + swz / 64; C = (st & 1) * 32 + (swz % 64) / 2; }
__host__ __device__ __forceinline__ int perm32(int rho) { const int n = rho >> 4, i = rho & 15; return 8 * (i >> 2) + 4 * n + (i & 3); }

struct Unit { int pm, pn, ks; };
struct Gemm { const bf16_t* A; const bf16_t* Bt; int M, N, K, ld; };

struct StaticOrder {
    static constexpr bool OPAQUE_K = false;
    int nM, nN, nwg, G, c;
    __device__ void init(int M, int N, int G_, int c_) { nM = M / BM; nN = N / BM; nwg = nM * nN; G = G_; c = c_; }
    __device__ bool next(int i, Unit& u) const {
        const long L = (long)i * G + c; if (L >= nwg) return false;
        int wgid = (int)L; { const int q = nwg / NXCD, r = nwg % NXCD, xcd = wgid % NXCD, off = wgid / NXCD; wgid = (xcd < r ? xcd * (q + 1) : r * (q + 1) + (xcd - r) * q) + off; }
        const int nig = WGM * nN, gid = wgid / nig, fm = gid * WGM, gsz = (nM - fm) < WGM ? (nM - fm) : WGM;
        u.pm = fm + ((wgid % nig) % gsz); u.pn = (wgid % nig) / gsz; u.ks = 0; return true;
    }
};
struct RectOrder {
    static constexpr bool OPAQUE_K = false;
    StaticOrder so; int n1, n2m, n2n, pm0;
    __device__ void init(int M1, int N1, int n2m_, int n2n_, int G_, int c_) { so.init(M1, N1, G_, c_); n1 = so.nwg; n2m = n2m_; n2n = n2n_; pm0 = so.nM; }
    __device__ bool next(int i, Unit& u) const {
        const long L = (long)i * so.G + so.c;
        if (L < n1) return so.next(i, u);
        const int idx = (int)(L - n1); if (idx >= n2m * n2n) return false;
        u.pm = pm0 + idx % n2m; u.pn = idx / n2m; u.ks = 0; return true;
    }
};
struct LoraOrder {
    static constexpr bool OPAQUE_K = true;
    StaticOrder so;
    __device__ bool next(int i, Unit& u) const { if (!so.next(i, u)) return false; u.ks = u.pn >= 16 ? 1 : 0; return true; }
};
struct SplitOrder {
    static constexpr bool OPAQUE_K = false;
    int nm, nn, ns, pm0, G, c;
    __device__ bool next(int i, Unit& u) const {
        const long L = (long)i * G + c; if (L >= (long)nm * nn * ns) return false;
        const int idx = (int)L; u.ks = idx % ns; const int tile = idx / ns; u.pm = pm0 + tile % nm; u.pn = tile / nm; return true;
    }
};

template <class Epi, class Order>
__device__ __forceinline__ void gemm_phase(LAS unsigned char* lds, const Gemm g, const Order& S, const Epi& E) {
    const int tid = threadIdx.x, wid = __builtin_amdgcn_readfirstlane(tid >> 6), lane = tid & 63, wr = wid >> 2, wc = wid & 3, fr = lane & 15, fq = lane >> 4;
    int K = g.K; if (Order::OPAQUE_K) asm volatile("" : "+s"(K));
    const int nt = K / BK;
    unsigned voffA[2], voffB[2];
#pragma unroll
    for (int i = 0; i < 2; ++i) { int R, C; stage_rc(tid * 16 + i * 8192, R, C); const int Rb = Epi::PERM ? ((R & ~31) + perm32(R & 31)) : R;
        voffA[i] = (unsigned)(R * g.ld + C) * 2u; voffB[i] = (unsigned)(Rb * g.ld + C) * 2u; }
    const size_t kstep = (size_t)(BK * 2);
    const size_t hstep = (size_t)HALF * g.ld * 2;
    const size_t sstep = (size_t)K * 2;
    const size_t tstep = 2 * hstep;
    const unsigned ldsw = (unsigned)wid * 1024u;
    const int aoff = lds_byte(wr * 64 + fr, fq * 8), boff = lds_byte(wc * 32 + fr, fq * 8);
#define PG8_SA(b, h) (((b) * 2 + (h)) * HTB)
#define PG8_SB(b, h) ((4 + (b) * 2 + (h)) * HTB)
#define PG8_STAGE(bufoff, gbase, voff) do { _Pragma("unroll") for (int _i = 0; _i < 2; ++_i) \
        __builtin_amdgcn_global_load_lds((const unsigned*)((const char*)(gbase) + (voff)[_i]), (LAS unsigned*)(lds + (bufoff) + ldsw + _i * 8192), 16, 0, 0); } while (0)
#define PG8_LDA(dst, b, h) do { _Pragma("unroll") for (int m = 0; m < 4; ++m) _Pragma("unroll") for (int k = 0; k < 2; ++k) dst[m][k] = *(const LAS bf16x8*)(lds + PG8_SA(b, h) + aoff + m * 2048 + k * 1024); } while (0)
#define PG8_LDB(dst, b, h) do { _Pragma("unroll") for (int n = 0; n < 2; ++n) _Pragma("unroll") for (int k = 0; k < 2; ++k) dst[n][k] = *(const LAS bf16x8*)(lds + PG8_SB(b, h) + boff + n * 2048 + k * 1024); } while (0)
#define PG8_MMA(ai, bj, At, Bt) do { __builtin_amdgcn_s_setprio(1); _Pragma("unroll") for (int m = 0; m < 4; ++m) _Pragma("unroll") for (int n = 0; n < 2; ++n) _Pragma("unroll") for (int k = 0; k < 2; ++k) \
        acc[ai][bj][m][n] = __builtin_amdgcn_mfma_f32_16x16x32_bf16(Bt[n][k], At[m][k], acc[ai][bj][m][n], 0, 0, 0); __builtin_amdgcn_s_setprio(0); } while (0)
#define PG8_WAIT_V(n) asm volatile("s_waitcnt vmcnt(" #n ")" ::: "memory")
#define PG8_WAIT_L(n) asm volatile("s_waitcnt lgkmcnt(" #n ")" ::: "memory")
#define PG8_BAR __builtin_amdgcn_s_barrier()
#define PG8_SCHED __builtin_amdgcn_sched_barrier(0)
    Unit cur, nxt; int ui = 0;
    if (!S.next(0, cur)) return;
    f32x4 acc[2][2][4][2];
#pragma unroll
    for (int a = 0; a < 2; ++a)
#pragma unroll
        for (int b = 0; b < 2; ++b)
#pragma unroll
            for (int m = 0; m < 4; ++m)
#pragma unroll
                for (int n = 0; n < 2; ++n) acc[a][b][m][n] = (f32x4){0.f, 0.f, 0.f, 0.f};
    bf16x8 At[4][2], B0[2][2], B1[2][2];
    const char* cA = (const char*)g.A + (size_t)cur.pm * tstep + (size_t)cur.ks * sstep; const char* cB = (const char*)g.Bt + (size_t)cur.pn * tstep + (size_t)cur.ks * sstep;
    PG8_STAGE(PG8_SB(0, 0), cB, voffB); PG8_STAGE(PG8_SA(0, 0), cA, voffA); PG8_STAGE(PG8_SB(0, 1), cB + hstep, voffB); PG8_STAGE(PG8_SA(0, 1), cA + hstep, voffA);
    if (wr == 1) PG8_BAR;
    PG8_WAIT_V(4); PG8_BAR;
    PG8_STAGE(PG8_SB(1, 0), cB + kstep, voffB); PG8_STAGE(PG8_SA(1, 0), cA + kstep, voffA); PG8_STAGE(PG8_SB(1, 1), cB + hstep + kstep, voffB);
    PG8_WAIT_V(6); PG8_BAR;
    for (;;) {
        const bool has_next = S.next(ui + 1, nxt);
        const char* nA = has_next ? (const char*)g.A + (size_t)nxt.pm * tstep + (size_t)nxt.ks * sstep : cA; const char* nB = has_next ? (const char*)g.Bt + (size_t)nxt.pn * tstep + (size_t)nxt.ks * sstep : cB;
#pragma nounroll
        for (int t = 0; t < nt; t += 2) {
            const bool last = (t == nt - 2);
            const char* a1 = cA + (size_t)(t + 1) * kstep;
            const char* a2 = last ? nA : cA + (size_t)(t + 2) * kstep; const char* b2 = last ? nB : cB + (size_t)(t + 2) * kstep;
            const char* a3 = a2 + kstep; const char* b3 = b2 + kstep;
            PG8_LDB(B0, 0, 0); PG8_SCHED; PG8_LDA(At, 0, 0); PG8_STAGE(PG8_SA(1, 1), a1 + hstep, voffA);
            PG8_WAIT_L(8); PG8_BAR; PG8_WAIT_L(0); PG8_MMA(0, 0, At, B0); PG8_BAR; PG8_SCHED;
            PG8_LDB(B1, 0, 1); PG8_STAGE(PG8_SB(0, 0), b2, voffB);
            PG8_BAR; PG8_WAIT_L(0); PG8_MMA(0, 1, At, B1); PG8_BAR;
            PG8_LDA(At, 0, 1); PG8_STAGE(PG8_SA(0, 0), a2, voffA);
            PG8_BAR; PG8_WAIT_L(0); PG8_MMA(1, 0, At, B0); PG8_BAR; PG8_SCHED;
            PG8_STAGE(PG8_SB(0, 1), b2 + hstep, voffB);
            PG8_WAIT_V(6); PG8_BAR; PG8_MMA(1, 1, At, B1); PG8_BAR;
            PG8_LDB(B0, 1, 0); PG8_SCHED; PG8_LDA(At, 1, 0); PG8_STAGE(PG8_SA(0, 1), a2 + hstep, voffA);
            PG8_WAIT_L(8); PG8_BAR; PG8_WAIT_L(0); PG8_MMA(0, 0, At, B0); PG8_BAR; PG8_SCHED;
            PG8_LDB(B1, 1, 1); PG8_STAGE(PG8_SB(1, 0), b3, voffB);
            PG8_BAR; PG8_WAIT_L(0); PG8_MMA(0, 1, At, B1); PG8_BAR;
            PG8_LDA(At, 1, 1); PG8_STAGE(PG8_SA(1, 0), a3, voffA);
            PG8_BAR; PG8_WAIT_L(0); PG8_MMA(1, 0, At, B0); PG8_BAR; PG8_SCHED;
            PG8_STAGE(PG8_SB(1, 1), b3 + hstep, voffB);
            PG8_WAIT_V(6); PG8_BAR; PG8_MMA(1, 1, At, B1); PG8_BAR;
        }
        E(acc, cur, wr, wc, fr, fq);
        if (!has_next) break;
#pragma unroll
        for (int a = 0; a < 2; ++a)
#pragma unroll
            for (int b = 0; b < 2; ++b)
#pragma unroll
                for (int m = 0; m < 4; ++m)
#pragma unroll
                    for (int n = 0; n < 2; ++n) acc[a][b][m][n] = (f32x4){0.f, 0.f, 0.f, 0.f};
        cur = nxt; cA = nA; cB = nB; ++ui;
    }
    PG8_WAIT_V(0);
    if (wr == 0) PG8_BAR;
    PG8_BAR;
#undef PG8_SA
#undef PG8_SB
#undef PG8_STAGE
#undef PG8_LDA
#undef PG8_LDB
#undef PG8_MMA
#undef PG8_WAIT_V
#undef PG8_WAIT_L
#undef PG8_BAR
#undef PG8_SCHED
}
}

struct EpiSwiglu {
    static constexpr bool PERM = true;
    bf16_t* O;
    __device__ __forceinline__ void operator()(const f32x4 (&acc)[2][2][4][2], const pg8::Unit& u, int wr, int wc, int fr, int fq) const {
        const int row0 = u.pm * 256 + wr * 64 + fr, col0 = u.pn * 128 + wc * 32 + 8 * fq;
#pragma unroll
        for (int ai = 0; ai < 2; ++ai)
#pragma unroll
            for (int m = 0; m < 4; ++m) {
                bf16_t* rowp = O + (size_t)(row0 + ai * 128 + m * 16) * DFF + col0;
                const f32x4 g0 = acc[ai][0][m][0], g1 = acc[ai][0][m][1], u0 = acc[ai][1][m][0], u1 = acc[ai][1][m][1];
                u32x4 w;
                w.x = cvt_pk_bf16(siluf(g0[0]) * u0[0], siluf(g0[1]) * u0[1]); w.y = cvt_pk_bf16(siluf(g0[2]) * u0[2], siluf(g0[3]) * u0[3]);
                w.z = cvt_pk_bf16(siluf(g1[0]) * u1[0], siluf(g1[1]) * u1[1]); w.w = cvt_pk_bf16(siluf(g1[2]) * u1[2], siluf(g1[3]) * u1[3]);
                *(u32x4*)rowp = w;
            }
    }
};
struct EpiF16 {
    static constexpr bool PERM = true;
    f16_t* O; int ldc;
    __device__ __forceinline__ void operator()(const f32x4 (&acc)[2][2][4][2], const pg8::Unit& u, int wr, int wc, int fr, int fq) const {
        const int row0 = u.pm * 256 + wr * 64 + fr, col0 = u.pn * 256 + wc * 32 + 8 * fq;
#pragma unroll
        for (int ai = 0; ai < 2; ++ai)
#pragma unroll
            for (int m = 0; m < 4; ++m) {
                f16_t* rowp = O + (size_t)(row0 + ai * 128 + m * 16) * ldc + col0;
#pragma unroll
                for (int bj = 0; bj < 2; ++bj) { const f32x4 v0 = acc[ai][bj][m][0], v1 = acc[ai][bj][m][1];
                    u32x4 w; w.x = pk_f16(v0[0], v0[1]); w.y = pk_f16(v0[2], v0[3]); w.z = pk_f16(v1[0], v1[1]); w.w = pk_f16(v1[2], v1[3]);
                    *(u32x4*)(rowp + bj * 128) = w; }
            }
    }
};
struct EpiLora {
    static constexpr bool PERM = true;
    f16_t* L; const float* bias;
    __device__ __forceinline__ void operator()(const f32x4 (&acc)[2][2][4][2], const pg8::Unit& u, int wr, int wc, int fr, int fq) const {
        const int reg = u.pn >> 2;
        const int row0 = u.pm * 256 + wr * 64 + fr, cc0 = (u.pn & 3) * 256 + wc * 32 + 8 * fq;
        f16_t* base = L + (size_t)reg * MT * RW + (size_t)row0 * RW + cc0;
        const float* bp = bias + reg * RW + cc0;
        const float sc = reg < 2 ? 0.6065306597126334f : 1.0f;
        const bool act = reg < 4;
        f32x4 bva[2][2];
#pragma unroll
        for (int bj = 0; bj < 2; ++bj)
#pragma unroll
            for (int n = 0; n < 2; ++n) bva[bj][n] = *(const f32x4*)(bp + bj * 128 + 4 * n);
#pragma unroll
        for (int bj = 0; bj < 2; ++bj)
#pragma unroll
            for (int n = 0; n < 2; ++n) {
                const f32x4 bv = bva[bj][n];
#pragma unroll
                for (int ai = 0; ai < 2; ++ai)
#pragma unroll
                    for (int m = 0; m < 4; ++m) {
                        f32x4 v = acc[ai][bj][m][n] + bv;
#pragma unroll
                        for (int j = 0; j < 4; ++j) { const float sg = sc * sigm(v[j]); v[j] = act ? sg : v[j]; }
                        u32x2 w; w.x = pk_f16(v[0], v[1]); w.y = pk_f16(v[2], v[3]);
                        *(u32x2*)(base + (size_t)(ai * 128 + m * 16) * RW + bj * 128 + 4 * n) = w;
                    }
            }
    }
};
struct EpiPartial {
    static constexpr bool PERM = false;
    float* part;
    __device__ __forceinline__ void operator()(const f32x4 (&acc)[2][2][4][2], const pg8::Unit& u, int wr, int wc, int fr, int fq) const {
        float* base = part + (size_t)u.ks * MC * D + (size_t)((u.pm - MX / 256) * 256 + wr * 64 + fr) * D + u.pn * 256 + wc * 32 + 4 * fq;
#pragma unroll
        for (int ai = 0; ai < 2; ++ai)
#pragma unroll
            for (int m = 0; m < 4; ++m)
#pragma unroll
                for (int bj = 0; bj < 2; ++bj)
#pragma unroll
                    for (int n = 0; n < 2; ++n) *(f32x4*)(base + (size_t)(ai * 128 + m * 16) * D + bj * 128 + n * 16) = acc[ai][bj][m][n];
    }
};
struct EpiResid {
    static constexpr bool PERM = false;
    const float* Xx; const float* Xc; float* Yx; float* Yc;
    const f32x2* stats; const float* lg; const float* lb;
    const float* modv; int gslot; float gscale;
    __device__ __forceinline__ void operator()(const f32x4 (&acc)[2][2][4][2], const pg8::Unit& u, int wr, int wc, int fr, int fq) const {
        const bool isx = u.pm < (MX / 256);
        const int mr = isx ? (u.pm >> 4) : 8;
        const float* gate = modv + (size_t)mr * MODW + gslot * D;
        const int lrow0 = (isx ? u.pm : u.pm - MX / 256) * 256 + wr * 64 + fr;
        const float* src = isx ? Xx : Xc; float* dst = isx ? Yx : Yc;
        const int grow0 = u.pm * 256 + wr * 64 + fr;
        f32x2 stv[2][4];
#pragma unroll
        for (int ai = 0; ai < 2; ++ai)
#pragma unroll
            for (int m = 0; m < 4; ++m) stv[ai][m] = stats ? stats[grow0 + ai * 128 + m * 16] : (f32x2){0.f, 1.f};
#pragma unroll
        for (int bj = 0; bj < 2; ++bj)
#pragma unroll
            for (int n = 0; n < 2; ++n) {
                const int col = u.pn * 256 + bj * 128 + wc * 32 + n * 16 + 4 * fq;
                const f32x4 gv = *(const f32x4*)(gate + col) * gscale;
                f32x4 lgv = (f32x4){1.f, 1.f, 1.f, 1.f}, lbv = (f32x4){0.f, 0.f, 0.f, 0.f};
                if (stats) { lgv = *(const f32x4*)(lg + col); lbv = *(const f32x4*)(lb + col); }
                f32x4 xv[2][4];
#pragma unroll
                for (int ai = 0; ai < 2; ++ai)
#pragma unroll
                    for (int m = 0; m < 4; ++m) xv[ai][m] = *(const f32x4*)(src + (size_t)(lrow0 + ai * 128 + m * 16) * D + col);
#pragma unroll
                for (int ai = 0; ai < 2; ++ai)
#pragma unroll
                    for (int m = 0; m < 4; ++m) {
                        const size_t off = (size_t)(lrow0 + ai * 128 + m * 16) * D + col;
                        f32x4 x = xv[ai][m];
                        if (stats) x = (x - stv[ai][m].x) * stv[ai][m].y * lgv + lbv;
                        *(f32x4*)(dst + off) = ALPHA * x + gv * acc[ai][bj][m][n];
                    }
            }
    }
};

#define XB_TMO      128
#define XB_XCNT(j)  (256  + 64 * (j))
#define XB_XSUB(j)  (1280 + 64 * (j))
#define XB_XGEN(j)  (2304 + 64 * (j))
#define XB_TOP      3328
#define XB_TOPGEN   3392
#define XCD_BAR_WORDS 3456
#define XB_SPIN_CAP (1u << 18)

__device__ __forceinline__ unsigned xb_ld(unsigned* p)              { return __hip_atomic_load(p, __ATOMIC_RELAXED, __HIP_MEMORY_SCOPE_AGENT); }
__device__ __forceinline__ unsigned xb_add(unsigned* p, unsigned v) { return __hip_atomic_fetch_add(p, v, __ATOMIC_RELAXED, __HIP_MEMORY_SCOPE_AGENT); }
__device__ __forceinline__ unsigned xb_xcc_id() { return (unsigned)__builtin_amdgcn_s_getreg((3 << 11) | 20) & 0xFu; }
#define XB_SPIN(cond, bar) do { unsigned _sp = 0; while (cond) { __builtin_amdgcn_s_sleep(1); \
    if ((++_sp & 255u) == 0u) { if (xb_ld(&(bar)[XB_TMO])) break; if (_sp > XB_SPIN_CAP) { atomicAdd(&(bar)[XB_TMO], 1u); break; } } } } while (0)

struct XcdBarrier {
    unsigned* bar; unsigned x;
    volatile LAS unsigned* st;
};

__device__ __forceinline__ XcdBarrier xcd_barrier_post(unsigned* bar, volatile LAS unsigned* st) {
    XcdBarrier b; b.bar = bar; b.x = xb_xcc_id(); b.st = st;
    if (threadIdx.x == 0) (void)xb_add(&bar[XB_XCNT(b.x)], 1u);
    return b;
}
__device__ __forceinline__ void xcd_barrier_complete(unsigned* bar, unsigned x, unsigned& nloc, unsigned& nx) {
    const unsigned G = gridDim.x * gridDim.y * gridDim.z;
    unsigned sum, cnt, mine, sp = 0u;
    for (;;) {
        sum = 0u; cnt = 0u; mine = 0u;
#pragma unroll
        for (unsigned j = 0; j < 16; ++j) { const unsigned c = xb_ld(&bar[XB_XCNT(j)]); sum += c; cnt += (c > 0u) ? 1u : 0u; mine = (j == x) ? c : mine; }
        if (sum == G) break;
        __builtin_amdgcn_s_sleep(1);
        if ((++sp & 255u) == 0u) { if (xb_ld(&bar[XB_TMO])) break; if (sp > XB_SPIN_CAP) { atomicAdd(&bar[XB_TMO], 1u); break; } }
    }
    nloc = mine > 0u ? mine : 1u; nx = cnt > 0u ? cnt : 1u;
}

__device__ __forceinline__ void xcd_barrier(const XcdBarrier& b) {
    asm volatile("s_waitcnt vmcnt(0)" ::: "memory");
    __syncthreads();
    if (threadIdx.x == 0) {
        unsigned* bar = b.bar;
        __builtin_amdgcn_s_waitcnt(0);
        unsigned nloc = b.st[0], nx = b.st[1];
        if (nloc == 0u) { xcd_barrier_complete(bar, b.x, nloc, nx); b.st[0] = nloc; b.st[1] = nx; }
        const unsigned old = xb_add(&bar[XB_XSUB(b.x)], 1u);
        const unsigned gen = old / nloc;
        if (old + 1u == (gen + 1u) * nloc) {
            __builtin_amdgcn_fence(__ATOMIC_RELEASE, "agent");
            asm volatile("s_waitcnt vmcnt(0)" ::: "memory");
            const unsigned og = xb_add(&bar[XB_TOP], 1u);
            const unsigned tg = og / nx;
            if (og + 1u == (tg + 1u) * nx) xb_add(&bar[XB_TOPGEN], 1u);
            else XB_SPIN(xb_ld(&bar[XB_TOPGEN]) == tg, bar);
            __builtin_amdgcn_fence(__ATOMIC_ACQUIRE, "agent");
            xb_add(&bar[XB_XGEN(b.x)], 1u);
            asm volatile("s_waitcnt vmcnt(0)" ::: "memory");
        } else {
            XB_SPIN(xb_ld(&bar[XB_XGEN(b.x)]) == gen, bar);
            __builtin_amdgcn_fence(__ATOMIC_ACQUIRE, "agent");
            asm volatile("s_waitcnt vmcnt(0)" ::: "memory");
        }
    }
    __syncthreads();
}

struct Params { const float* in[29]; float* out; unsigned char* ws; int ph_lo, ph_hi; };
enum { I_X = 0, I_C, I_CTX, I_CCTX, I_WADA, I_BADA, I_LNG, I_LNB, I_WIA, I_WOA, I_WIB, I_WOB, I_WIN, I_MU, I_W0, I_WUP, I_A0, I_AUP, I_GUP, I_KK, I_KA, I_RK, I_GNG, I_GNB, I_GMG, I_GMB, I_GMWS, I_GMBS, I_WOUT };

template <bool SWI>
__device__ __forceinline__ void transpose_item(const float* W, int K, int N, bf16_t* WT, LAS float* scr, int item, int lane) {
    const int nblk = N / 32, kb = item / nblk, nb = item % nblk, k0 = 64 * kb, n0 = 32 * nb;
    float wv[32];
#pragma unroll
    for (int i = 0; i < 32; ++i) wv[i] = __builtin_nontemporal_load(W + (size_t)(k0 + 2 * i + (lane >> 5)) * N + n0 + (lane & 31));
#pragma unroll
    for (int i = 0; i < 32; ++i) scr[(2 * i + (lane >> 5)) * 33 + (lane & 31)] = wv[i];
    asm volatile("s_waitcnt lgkmcnt(0)" ::: "memory");
    int r0 = n0;
    if (SWI) { const int bj = n0 / DFF, j = n0 - bj * DFF; r0 = (j >> 7) * 256 + bj * 128 + (j & 127); }
    const int c = lane & 7;
#pragma unroll
    for (int j = 0; j < 4; ++j) { const int n = (lane >> 3) + 8 * j; const LAS float* s = scr + (8 * c) * 33 + n;
        u32x4 o; o.x = cvt_pk_bf16(s[0 * 33], s[1 * 33]); o.y = cvt_pk_bf16(s[2 * 33], s[3 * 33]); o.z = cvt_pk_bf16(s[4 * 33], s[5 * 33]); o.w = cvt_pk_bf16(s[6 * 33], s[7 * 33]);
        *(u32x4*)(WT + (size_t)(r0 + n) * K + k0 + 8 * c) = o; }
    asm volatile("s_waitcnt lgkmcnt(0)" ::: "memory");
}

struct TrItem { const float* W; bf16_t* WT; int K, N, k0, n0, r0; };
__device__ __forceinline__ TrItem tr_decode(const Params& p, unsigned char* ws, int it) {
    constexpr int I_1 = (D / 64) * (NWI / 32);
    const bool first = it < I_1; TrItem t;
    t.W = first ? p.in[I_WIB] : p.in[I_WOB]; t.WT = (bf16_t*)(ws + (first ? WS_WIB : WS_WOB)); t.K = first ? D : DFF; t.N = first ? NWI : D;
    const int item = first ? it : it - I_1, nblk = t.N / 32, kb = item / nblk, nb = item - kb * nblk;
    t.k0 = 64 * kb; t.n0 = 32 * nb;
    const int bj = t.n0 / DFF, j = t.n0 - bj * DFF;
    t.r0 = first ? ((j >> 7) * 256 + bj * 128 + (j & 127)) : t.n0;
    return t;
}
__device__ __forceinline__ void tr_load(const TrItem& t, int lane, float (&wv)[32]) {
#pragma unroll
    for (int i = 0; i < 32; ++i) wv[i] = __builtin_nontemporal_load(t.W + (size_t)(t.k0 + 2 * i + (lane >> 5)) * t.N + t.n0 + (lane & 31));
}
__device__ __forceinline__ void tr_finish(const TrItem& t, LAS float* scr, int lane, const float (&wv)[32]) {
#pragma unroll
    for (int i = 0; i < 32; ++i) scr[(2 * i + (lane >> 5)) * 33 + (lane & 31)] = wv[i];
    asm volatile("s_waitcnt lgkmcnt(0)" ::: "memory");
    const int c = lane & 7;
#pragma unroll
    for (int j = 0; j < 4; ++j) { const int n = (lane >> 3) + 8 * j; const LAS float* s = scr + (8 * c) * 33 + n;
        u32x4 o; o.x = cvt_pk_bf16(s[0 * 33], s[1 * 33]); o.y = cvt_pk_bf16(s[2 * 33], s[3 * 33]); o.z = cvt_pk_bf16(s[4 * 33], s[5 * 33]); o.w = cvt_pk_bf16(s[6 * 33], s[7 * 33]);
        *(u32x4*)(t.WT + (size_t)(t.r0 + n) * t.K + t.k0 + 8 * c) = o; }
    asm volatile("s_waitcnt lgkmcnt(0)" ::: "memory");
}
template <int PH>
__device__ __forceinline__ void ln_pass(const Params& p, LAS unsigned char* lds, unsigned char* ws, float* Yx, float* Yc, const float* modv, const float* lng, const float* lnb, f32x2* st1, f32x2* st2, bf16_t* R0, int gw, int NGW, int lane, int wave) {
    constexpr int ph = PH;
            const int j = ph == 4 ? 1 : 2; const int rows = ph == 4 ? MT : MX;
            f32x2* st = ph == 4 ? st1 : st2;
            const float* lg = lng + (j - 1) * D; const float* lb = lnb + (j - 1) * D;
            LAS float* Lg = (LAS float*)lds; LAS float* Lb = Lg + D; LAS float* Ls = Lb + D; LAS float* Lt = Ls + D;
            { const int tid_ = (int)threadIdx.x; *(LAS f32x4*)(Lg + tid_ * 4) = *(const f32x4*)(lg + tid_ * 4); *(LAS f32x4*)(Lb + tid_ * 4) = *(const f32x4*)(lb + tid_ * 4); }
            int cur_mr = -1;
            f32x4 nv[8];
            if (gw < rows) { const float* y0 = gw < MX ? Yx + (size_t)gw * D : p.in[I_CTX] + (size_t)(gw - MX) * D;
#pragma unroll
                for (int q = 0; q < 8; ++q) nv[q] = *(const f32x4*)(y0 + q * 256 + lane * 4); }
            for (int m = gw; m < rows; m += NGW) {
                const bool isx = m < MX; const int mr = isx ? (m >> 12) : 8;
                if (mr != cur_mr) {
                    const float* sh = modv + (size_t)mr * MODW + 3 * j * D; const int tid_ = (int)threadIdx.x;
                    __syncthreads();
                    *(LAS f32x4*)(Lt + tid_ * 4) = *(const f32x4*)(sh + tid_ * 4); *(LAS f32x4*)(Ls + tid_ * 4) = *(const f32x4*)(sh + D + tid_ * 4);
                    __syncthreads();
                    cur_mr = mr;
                }
                f32x4 v[8]; float s = 0.f;
#pragma unroll
                for (int q = 0; q < 8; ++q) v[q] = nv[q];
                { const int mn = m + NGW < rows ? m + NGW : m; const float* yn = mn < MX ? Yx + (size_t)mn * D : p.in[I_CTX] + (size_t)(mn - MX) * D;
#pragma unroll
                  for (int q = 0; q < 8; ++q) nv[q] = *(const f32x4*)(yn + q * 256 + lane * 4); }
                if (!isx) {
#pragma unroll
                    for (int q = 0; q < 8; ++q) {
                        const float* pp = (const float*)(ws + WS_PART) + (size_t)(m - MX) * D + q * 256 + lane * 4;
                        const f32x4 ps = (*(const f32x4*)pp + *(const f32x4*)(pp + (size_t)MC * D)) + (*(const f32x4*)(pp + (size_t)2 * MC * D) + *(const f32x4*)(pp + (size_t)3 * MC * D));
                        v[q] = ALPHA * v[q] + 0.5f * *(const f32x4*)(modv + (size_t)8 * MODW + 2 * D + q * 256 + lane * 4) * ps; }
                }
#pragma unroll
                for (int q = 0; q < 8; ++q) s += (v[q][0] + v[q][1]) + (v[q][2] + v[q][3]);
                const float mean = wave_sum(s) * (1.0f / D); float s2 = 0.f;
#pragma unroll
                for (int q = 0; q < 8; ++q) { v[q] = v[q] - mean; s2 += (v[q][0] * v[q][0] + v[q][1] * v[q][1]) + (v[q][2] * v[q][2] + v[q][3] * v[q][3]); }
                const float rstd = 1.0f / sqrtf(wave_sum(s2) * (1.0f / D) + LN_EPS);
                if (lane == 0) st[m] = (f32x2){mean, rstd};
                bf16_t* o = R0 + (size_t)m * D;
#pragma unroll
                for (int hq = 0; hq < 2; ++hq) {
                    f32x4 g4[4], b4[4], s4[4], t4[4];
#pragma unroll
                    for (int u = 0; u < 4; ++u) { const int c = (hq * 4 + u) * 256 + lane * 4; g4[u] = *(const LAS f32x4*)(Lg + c); b4[u] = *(const LAS f32x4*)(Lb + c); s4[u] = *(const LAS f32x4*)(Ls + c); t4[u] = *(const LAS f32x4*)(Lt + c); }
#pragma unroll
                    for (int u = 0; u < 4; ++u) { const int q = hq * 4 + u, c = q * 256 + lane * 4;
                        const f32x4 xn = v[q] * rstd * g4[u] + b4[u];
                        const f32x4 h = xn * (1.0f + s4[u]) + t4[u];
                        u32x2 w; w.x = cvt_pk_bf16(h[0], h[1]); w.y = cvt_pk_bf16(h[2], h[3]); *(u32x2*)(o + c) = w; }
                }
            }
            if (ph == 12) {
                __syncthreads();
                LAS float* scr = (LAS float*)(lds + wave * 16384);
                constexpr int NIT = (D / 64) * (NWI / 32) + (DFF / 64) * (D / 32);
                if (gw < NIT) {
                    TrItem t = tr_decode(p, ws, gw); float wv[32]; tr_load(t, lane, wv);
                    for (int it = gw; it < NIT; it += NGW) {
                        const TrItem tn = tr_decode(p, ws, it + NGW < NIT ? it + NGW : it); float wn[32]; tr_load(tn, lane, wn);
                        tr_finish(t, scr, lane, wv);
                        t = tn;
#pragma unroll
                        for (int i = 0; i < 32; ++i) wv[i] = wn[i];
                    }
                }
            }
}

__global__ void __launch_bounds__(512, 2) fwd_megakernel(Params p) {
    extern __shared__ __attribute__((aligned(16))) unsigned char lds_raw[];
    LAS unsigned char* lds = (LAS unsigned char*)lds_raw;
    const int tid = threadIdx.x, lane = tid & 63, wave = __builtin_amdgcn_readfirstlane(tid >> 6);
    const int G = gridDim.x, bid = blockIdx.x;
    const int gw = bid * 8 + wave, NGW = G * 8;
    unsigned char* ws = p.ws;
    float* modv = (float*)(ws + WS_MODV);
    f32x2* st1 = (f32x2*)(ws + WS_ST1); f32x2* st2 = (f32x2*)(ws + WS_ST2);
    bf16_t* R0 = (bf16_t*)(ws + WS_R0);
    float* Yx = p.out; float* Yc = (float*)(ws + WS_Y1C);
    const float* lng = p.in[I_LNG]; const float* lnb = p.in[I_LNB];

    cg::grid_group grid = cg::this_grid();
    const int lo = p.ph_lo, hi = p.ph_hi;
    volatile LAS unsigned* bst = (volatile LAS unsigned*)(lds + LDS_BYTES - 16);
    if (tid < 4) bst[tid] = 0u;
    __syncthreads();
    XcdBarrier xbar = xcd_barrier_post((unsigned*)ws, bst);
    if (hi > 1000) grid.sync();
#define IN(k) (lo <= (k) && (k) < hi)
#define SEAM(k) do { if (IN(k) && IN((k) + 1)) xcd_barrier(xbar); } while (0)
        if (PH_ON(0) && IN(0)) for (int rep_ = 0; rep_ < NREP(0); ++rep_) { if (rep_) xcd_barrier(xbar);
            LAS float* scr = (LAS float*)(lds + wave * 16384);
            constexpr int I_1 = (D / 64) * (NWI / 32), I_2 = (DFF / 64) * (D / 32), I_3 = (D / 64) * (INW / 32), I_4 = (D / 64) * (D / 32);
            for (int it = gw; it < I_1 + I_2 + I_3 + I_4; it += NGW) {
                int r = it;
                if (r < I_1) { transpose_item<true>(p.in[I_WIA], D, NWI, (bf16_t*)(ws + WS_WIA), scr, r, lane); continue; } r -= I_1;
                if (r < I_2) { transpose_item<false>(p.in[I_WOA], DFF, D, (bf16_t*)(ws + WS_WOA), scr, r, lane); continue; } r -= I_2;
                if (r < I_3) { transpose_item<false>(p.in[I_WIN], D, INW, (bf16_t*)(ws + WS_WIN), scr, r, lane); continue; } r -= I_3;
                transpose_item<false>(p.in[I_WOUT], D, D, (bf16_t*)(ws + WS_WOUT), scr, r, lane);
            }
            {
                bf16_t* LB = (bf16_t*)(ws + WS_LORAB);
                const float* wup = p.in[I_WUP]; const float* aup = p.in[I_AUP]; const float* gup = p.in[I_GUP];
                for (int i = bid * 512 + tid; i < NLORA * KLORA; i += G * 512) {
                    const int n = i >> 8, k = i & 255, reg = n >> 10, cc = n & 1023; float v = 0.f;
                    if (reg < 2) { if (k < 64) v = wup[((size_t)reg * 64 + k) * RW + cc]; }
                    else if (reg < 4) { if (k >= 64 && k < 128) v = aup[((size_t)(reg - 2) * 64 + (k - 64)) * RW + cc]; }
                    else { if (k >= 128) v = gup[(size_t)(k - 128) * RW + cc]; }
                    LB[i] = (bf16_t)(cvt_pk_bf16(v, 0.f) & 0xffffu);
                }
                float* LBI = (float*)(ws + WS_LBIAS);
                for (int i = bid * 512 + tid; i < NLORA; i += G * 512) LBI[i] = i < 2048 ? p.in[I_W0][i] : (i < 4096 ? p.in[I_A0][i - 2048] : 0.f);
                bf16_t* WSB = (bf16_t*)(ws + WS_WSB); const float* gws = p.in[I_GMWS];
                for (int i = bid * 512 + tid; i < 16 * 128 * 128; i += G * 512) WSB[i] = (bf16_t)(cvt_pk_bf16(gws[i], 0.f) & 0xffffu);
            }
            __syncthreads();
            {
                LAS float* sb = (LAS float*)lds;
                LAS float* red = (LAS float*)(lds + 9 * 2048 * 4);
                for (int i = tid; i < 9 * D; i += 512) { const int r = i >> 11, k = i & 2047; const float v = r < 8 ? p.in[I_C][r * D + k] : p.in[I_CCTX][k]; sb[i] = siluf(v); }
                __syncthreads();
                const float* wada = p.in[I_WADA]; const float* bada = p.in[I_BADA];
                for (int tk = bid; tk < MODW / 32; tk += G) {
                    const int c0 = tk * 32, col = lane & 31, kh = lane >> 5;
                    float a[9];
#pragma unroll
                    for (int r = 0; r < 9; ++r) a[r] = 0.f;
                    const float* wp = wada + (size_t)(wave * 256 + kh) * MODW + c0 + col;
                    const LAS float* sp = sb + wave * 256 + kh;
                    for (int k16 = 0; k16 < 256; k16 += 32) {
                        float wv[16];
#pragma unroll
                        for (int j = 0; j < 16; ++j) wv[j] = __builtin_nontemporal_load(wp + (size_t)(k16 + 2 * j) * MODW);
#pragma unroll
                        for (int j = 0; j < 16; ++j)
#pragma unroll
                            for (int r = 0; r < 9; ++r) a[r] += sp[r * D + k16 + 2 * j] * wv[j];
                    }
#pragma unroll
                    for (int r = 0; r < 9; ++r) { a[r] += __shfl_xor(a[r], 32); if (lane < 32) red[(wave * 9 + r) * 32 + col] = a[r]; }
                    __syncthreads();
                    for (int i = tid; i < 9 * 32; i += 512) { const int r = i >> 5, l = i & 31; float sacc = 0.f;
#pragma unroll
                        for (int w = 0; w < 8; ++w) sacc += red[(w * 9 + r) * 32 + l];
                        modv[(size_t)r * MODW + c0 + l] = sacc + bada[c0 + l]; }
                    __syncthreads();
                }
            }
        } SEAM(0);

        if (PH_ON(1) && IN(1)) for (int rep_ = 0; rep_ < NREP(1); ++rep_) { if (rep_) xcd_barrier(xbar);
            LAS float* Ls = (LAS float*)lds; LAS float* Lt = Ls + D; int cur_mr = -1;
            f32x4 nx[8];
            { const float* x0 = gw < MX ? p.in[I_X] + (size_t)gw * D : p.in[I_CTX] + (size_t)(gw - MX) * D;
#pragma unroll
              for (int j = 0; j < 8; ++j) nx[j] = *(const f32x4*)(x0 + j * 256 + lane * 4); }
            for (int m = gw; m < MT; m += NGW) {
                const bool isx = m < MX; const int mr = isx ? (m >> 12) : 8;
                if (mr != cur_mr) {
                    const float* sh = modv + (size_t)mr * MODW;
                    __syncthreads();
                    *(LAS f32x4*)(Lt + tid * 4) = *(const f32x4*)(sh + tid * 4); *(LAS f32x4*)(Ls + tid * 4) = *(const f32x4*)(sh + D + tid * 4);
                    __syncthreads();
                    cur_mr = mr;
                }
                bf16_t* o = R0 + (size_t)m * D;
                f32x4 xv[8], sv[8], tv[8];
#pragma unroll
                for (int j = 0; j < 8; ++j) { const int c = j * 256 + lane * 4; xv[j] = nx[j]; sv[j] = *(const LAS f32x4*)(Ls + c); tv[j] = *(const LAS f32x4*)(Lt + c); }
                { const int mn = m + NGW < MT ? m + NGW : m; const float* xn = mn < MX ? p.in[I_X] + (size_t)mn * D : p.in[I_CTX] + (size_t)(mn - MX) * D;
#pragma unroll
                  for (int j = 0; j < 8; ++j) nx[j] = *(const f32x4*)(xn + j * 256 + lane * 4); }
#pragma unroll
                for (int j = 0; j < 8; ++j) { const int c = j * 256 + lane * 4;
                    const f32x4 h = xv[j] * (1.0f + sv[j]) + tv[j]; u32x2 w; w.x = cvt_pk_bf16(h[0], h[1]); w.y = cvt_pk_bf16(h[2], h[3]); *(u32x2*)(o + c) = w; }
            }
        } SEAM(1);
        if (PH_ON(2) && IN(2)) for (int rep_ = 0; rep_ < NREP(2); ++rep_) { if (rep_) xcd_barrier(xbar);
            pg8::Gemm g{R0, (const bf16_t*)(ws + WS_WIA), MT, NWI, D, D}; pg8::StaticOrder S; S.init(MT, NWI, G, bid);
            EpiSwiglu E{(bf16_t*)(ws + WS_R1)};
            pg8::gemm_phase<EpiSwiglu, pg8::StaticOrder>(lds, g, S, E);
        } SEAM(2);
        if (PH_ON(3) && IN(3)) for (int rep_ = 0; rep_ < NREP(3); ++rep_) { if (rep_) xcd_barrier(xbar);
            pg8::Gemm g{(const bf16_t*)(ws + WS_R1), (const bf16_t*)(ws + WS_WOA), MX, D, DFF, DFF}; pg8::StaticOrder S; S.init(MX, D, G, bid);
            EpiResid E{p.in[I_X], p.in[I_CTX], Yx, Yc, nullptr, nullptr, nullptr, modv, 2, 0.5f};
            pg8::gemm_phase<EpiResid, pg8::StaticOrder>(lds, g, S, E);
            pg8::Gemm g2{(const bf16_t*)(ws + WS_R1), (const bf16_t*)(ws + WS_WOA), MC, D, DFF / 4, DFF}; pg8::SplitOrder S2{MC / 256, D / 256, 4, MX / 256, G, bid};
            EpiPartial E2{(float*)(ws + WS_PART)};
            pg8::gemm_phase<EpiPartial, pg8::SplitOrder>(lds, g2, S2, E2);
        } SEAM(3);
        if (PH_ON(4) && IN(4)) for (int rep_ = 0; rep_ < NREP(4); ++rep_) { if (rep_) xcd_barrier(xbar); ln_pass<4>(p, lds, ws, Yx, Yc, modv, lng, lnb, st1, st2, R0, gw, NGW, lane, wave); } SEAM(4);
        if (PH_ON(5) && IN(5)) for (int rep_ = 0; rep_ < NREP(5); ++rep_) { if (rep_) xcd_barrier(xbar);
            pg8::Gemm g{R0, (const bf16_t*)(ws + WS_WIN), MT, INW, D, D}; pg8::RectOrder S; S.init(MX, INW, MC / 256, RIN / 256, G, bid);
            EpiF16 E{(f16_t*)(ws + WS_R1), INW};
            pg8::gemm_phase<EpiF16, pg8::RectOrder>(lds, g, S, E);
        } SEAM(5);
        if (PH_ON(6) && IN(6)) for (int rep_ = 0; rep_ < NREP(6); ++rep_) { if (rep_) xcd_barrier(xbar);
            const f16_t* P = (const f16_t*)(ws + WS_R1);
            f16_t* RKV = (f16_t*)(ws + WS_R2); bf16_t* AL = (bf16_t*)(ws + WS_ALORA);
            const float* mu = p.in[I_MU];
            for (int m = gw; m < MT; m += NGW) {
                const bool isx = m < MX;
                const f16_t* pr = P + (size_t)m * INW;
                bool okA, okB, okC = false, okD = false; long dA, dB, dC = 0, dD = 0;
                if (isx) { const int t = m & 4095, gr = t >> 6, gc = t & 63; okA = gc > 0; okB = gc < 63; okC = gr > 0; okD = gr < 63; dA = -1; dB = 1; dC = -64; dD = 64; }
                else { const int t = (m - MX) & 255; okA = t > 0; okB = t < 255; dA = -1; dB = 1; }
                const f16_t* pA = okA ? pr + dA * INW : pr; const f16_t* pB = okB ? pr + dB * INW : pr;
                const f16_t* pC = okC ? pr + dC * INW : pr; const f16_t* pD = okD ? pr + dD * INW : pr;
                const u32x4 z = (u32x4){0u, 0u, 0u, 0u};
                for (int base = 0; base < 7; base += 4) {
                    u32x4 own[4], vA[4], vB[4], vC[4], vD[4]; f32x4 mu0a[4], mu1a[4];
#pragma unroll
                    for (int u = 0; u < 4; ++u) { int ci = lane + 64 * (base + u); ci = ci < RIN / 8 ? ci : RIN / 8 - 1; const int c = ci * 8;
                        own[u] = *(const u32x4*)(pr + c); vA[u] = *(const u32x4*)(pA + c); vB[u] = *(const u32x4*)(pB + c); vC[u] = *(const u32x4*)(pC + c); vD[u] = *(const u32x4*)(pD + c);
                        mu0a[u] = *(const f32x4*)(mu + c); mu1a[u] = *(const f32x4*)(mu + c + 4); }
#pragma unroll
                    for (int u = 0; u < 4; ++u) {
                        const int ci = lane + 64 * (base + u); const int c = ci * 8;
                        if (ci < RIN / 8) {
                            float fo[8], fA[8], fB[8], fC[8], fD[8], xs[8];
                            h8_to_f(own[u], fo); h8_to_f(okA ? vA[u] : z, fA); h8_to_f(okB ? vB[u] : z, fB); h8_to_f(okC ? vC[u] : z, fC); h8_to_f(okD ? vD[u] : z, fD);
                            const f32x4 mu0 = mu0a[u], mu1 = mu1a[u];
#pragma unroll
                            for (int j = 0; j < 8; ++j) {
                                float sh;
                                if (isx) sh = (j & 3) == 0 ? fA[j] : (j & 3) == 1 ? fB[j] : (j & 3) == 2 ? fC[j] : fD[j];
                                else sh = (j & 1) == 0 ? fA[j] : fB[j];
                                const float mj = j < 4 ? mu0[j] : mu1[j - 4];
                                xs[j] = fo[j] + (sh - fo[j]) * mj;
                            }
                            if (c < 3 * RW) {
                                u32x4 w; w.x = pk_f16(xs[0], xs[1]); w.y = pk_f16(xs[2], xs[3]); w.z = pk_f16(xs[4], xs[5]); w.w = pk_f16(xs[6], xs[7]);
                                *(u32x4*)(RKV + (size_t)m * 3072 + c) = w;
                            } else {
                                const int cl = c - 3 * RW;
#pragma unroll
                                for (int j = 0; j < 8; ++j) { if (cl < 64) xs[j] = tanh_f(xs[j]); else if (cl >= 128) xs[j] = sigm(xs[j]); }
                                u32x4 w; w.x = cvt_pk_bf16(xs[0], xs[1]); w.y = cvt_pk_bf16(xs[2], xs[3]); w.z = cvt_pk_bf16(xs[4], xs[5]); w.w = cvt_pk_bf16(xs[6], xs[7]);
                                *(u32x4*)(AL + (size_t)m * 256 + cl) = w;
                            }
                        }
                    }
                }
            }
            {
                bf16_t* VT = (bf16_t*)(ws + WS_VT);
                const float* gg = p.in[I_GMG]; const float* gb = p.in[I_GMB];
                for (int tk = gw; tk < NB * 32 * 2 * 16; tk += NGW) {
                    const int g = tk & 15, hh = (tk >> 4) & 1, bn = tk >> 5;
                    const int q = hh * 64 + lane; const size_t m = (size_t)bn * 128 + q;
                    const f16_t* src = P + m * INW + RIN + RW + g * 64;
                    float v[64]; float s = 0.f;
#pragma unroll
                    for (int i = 0; i < 8; ++i) { float f[8]; h8_to_f(*(const u32x4*)(src + i * 8), f);
#pragma unroll
                        for (int j = 0; j < 8; ++j) { v[i * 8 + j] = gelu_t(f[j]); s += v[i * 8 + j]; } }
                    const float mean = s * (1.0f / 64.0f); float s2 = 0.f;
#pragma unroll
                    for (int d = 0; d < 64; ++d) { v[d] -= mean; s2 += v[d] * v[d]; }
                    const float rstd = 1.0f / sqrtf(s2 * (1.0f / 64.0f) + LN_EPS);
                    bf16_t* dst = VT + ((size_t)bn * 16 + g) * 64 * 128 + q;
#pragma unroll
                    for (int d = 0; d < 64; ++d) { const float o = v[d] * rstd * gg[g * 64 + d] + gb[g * 64 + d]; dst[d * 128] = (bf16_t)(cvt_pk_bf16(o, 0.f) & 0xffffu); }
                }
            }
        } SEAM(6);
        if (PH_ON(7) && IN(7)) for (int rep_ = 0; rep_ < NREP(7); ++rep_) { if (rep_) xcd_barrier(xbar);
            const f16_t* P = (const f16_t*)(ws + WS_R1);
            const bf16_t* VT = (const bf16_t*)(ws + WS_VT); const bf16_t* WSB = (const bf16_t*)(ws + WS_WSB);
            const float* bs = p.in[I_GMBS];
            const int fr = lane & 15, fq = lane >> 4;
            for (int tk = gw; tk < NB * 32 * 16; tk += NGW) {
                const int g = tk & 15, bn = tk >> 4;
                const bf16_t* vb = VT + ((size_t)bn * 16 + g) * 64 * 128;
                const bf16_t* wb = WSB + (size_t)g * 128 * 128;
                bf16x8 vf[4][4];
#pragma unroll
                for (int nt = 0; nt < 4; ++nt)
#pragma unroll
                    for (int kk = 0; kk < 4; ++kk) vf[nt][kk] = *(const bf16x8*)(vb + (nt * 16 + fr) * 128 + kk * 32 + fq * 8);
                bf16x8 wfn[4]; u32x2 un[4]; float bsn;
#define P7_LOAD(mt_) do { const int pt_ = (mt_) * 16 + fr; const size_t m_ = (size_t)bn * 128 + pt_; \
                    _Pragma("unroll") for (int kk = 0; kk < 4; ++kk) wfn[kk] = *(const bf16x8*)(wb + pt_ * 128 + kk * 32 + fq * 8); \
                    _Pragma("unroll") for (int nt = 0; nt < 4; ++nt) un[nt] = *(const u32x2*)(P + m_ * INW + RIN + g * 64 + nt * 16 + fq * 4); \
                    bsn = bs[g * 128 + pt_]; } while (0)
                P7_LOAD(0);
#pragma unroll 2
                for (int mt = 0; mt < 8; ++mt) {
                    bf16x8 wf[4]; u32x2 uc[4]; const float bsv = bsn;
#pragma unroll
                    for (int kk = 0; kk < 4; ++kk) { wf[kk] = wfn[kk]; uc[kk] = un[kk]; }
                    { const int mtn = mt < 7 ? mt + 1 : 7; P7_LOAD(mtn); }
                    f32x4 acc[4];
#pragma unroll
                    for (int nt = 0; nt < 4; ++nt) { acc[nt] = (f32x4){0.f, 0.f, 0.f, 0.f};
#pragma unroll
                        for (int kk = 0; kk < 4; ++kk) acc[nt] = __builtin_amdgcn_mfma_f32_16x16x32_bf16(vf[nt][kk], wf[kk], acc[nt], 0, 0, 0); }
                    const int pt = mt * 16 + fr; const size_t m = (size_t)bn * 128 + pt;
#pragma unroll
                    for (int nt = 0; nt < 4; ++nt) {
                        const int d0 = nt * 16 + fq * 4;
                        const h16x4 uh = __builtin_bit_cast(h16x4, uc[nt]);
                        float o[4];
#pragma unroll
                        for (int j = 0; j < 4; ++j) o[j] = gelu_t((float)uh[j]) * (acc[nt][j] + bsv);
                        u32x2 w; w.x = cvt_pk_bf16(o[0], o[1]); w.y = cvt_pk_bf16(o[2], o[3]);
                        *(u32x2*)(R0 + m * D + RW + g * 64 + d0) = w;
                    }
                }
#undef P7_LOAD
            }
        } SEAM(7);
        if (PH_ON(8) && IN(8)) for (int rep_ = 0; rep_ < NREP(8); ++rep_) { if (rep_) xcd_barrier(xbar);
            pg8::Gemm g{(const bf16_t*)(ws + WS_ALORA), (const bf16_t*)(ws + WS_LORAB), MT, NLORA, KLORA / 2, KLORA}; pg8::LoraOrder S; S.so.init(MT, NLORA, G, bid);
            EpiLora E{(f16_t*)(ws + WS_R1), (const float*)(ws + WS_LBIAS)};
            pg8::gemm_phase<EpiLora, pg8::LoraOrder>(lds, g, S, E);
        } SEAM(8);
        if (PH_ON(9) && IN(9)) for (int rep_ = 0; rep_ < NREP(9); ++rep_) { if (rep_) xcd_barrier(xbar);
            const f16_t* RKV = (const f16_t*)(ws + WS_R2); const f16_t* L = (const f16_t*)(ws + WS_R1);
            f16_t* YSC = (f16_t*)(ws + WS_YSC);
            constexpr int TC = 32, NCH = (CTXL + SEQ) / TC, NSUB = 2 * NCH, LD64 = 72, LD32 = 40;
            constexpr int RS = 68, AS = 32 * RS;
            LAS float* raw = (LAS float*)lds;
            LAS float* ybuf = (LAS float*)(lds + 52224);
            LAS float* AabT = (LAS float*)(lds + 120320);
            LAS float* ScT = (LAS float*)(lds + 121344);
            LAS float* ScT2 = (LAS float*)(lds + 121600);
            LAS float* ScM = (LAS float*)(lds + 121856);
            LAS bf16_t* XTa = (LAS bf16_t*)(lds + 122112);
            LAS bf16_t* UTa = (LAS bf16_t*)(lds + 127232);
            LAS bf16_t* SB = (LAS bf16_t*)(lds + 132352);
#define D64(pb_, q_) ((LAS bf16_t*)(lds + 60416 + (pb_) * 9216 + (q_) * 2304))
#define D32(pb_, q_) ((LAS bf16_t*)(lds + 78848 + (pb_) * 15360 + (q_) * 5120))
#define P16B(pb_) ((LAS float*)(lds + 109568 + (pb_) * 256))
#define AMB(pb_, q_) ((LAS bf16_t*)(lds + 110080 + (pb_) * 5120 + (q_) * 1280))
            const int fr = lane & 15, fq = lane >> 4;
#define FRAG(M_, ld_, rb_, kk_) (*(const LAS bf16x8*)((M_) + ((rb_) + fr) * (ld_) + (kk_) * 32 + fq * 8))
#define LDSFENCE() asm volatile("s_waitcnt lgkmcnt(0)" ::: "memory")
            for (int sid = bid; sid < NB * NH * 2; sid += G) {
                const int dir = sid & 1, h = (sid >> 1) & 15, b = sid >> 5;
                const int ps = tid >> 4, kg = tid & 15, ch = h * 64 + 4 * kg;
                const f32x4 kkp = *(const f32x4*)(p.in[I_KK] + ch), kap = *(const f32x4*)(p.in[I_KA] + ch);
                const f16_t* Le = L + (size_t)dir * MT * RW; const f16_t* Li = L + (size_t)(2 + dir) * MT * RW;
                for (int i = tid; i < (141568 - 60416) / 4; i += 512) ((LAS unsigned*)(lds + 60416))[i] = 0u;
                f32x4 accS[4], accY = (f32x4){0.f, 0.f, 0.f, 0.f};
#pragma unroll
                for (int q = 0; q < 4; ++q) accS[q] = (f32x4){0.f, 0.f, 0.f, 0.f};
                u32x2 pr_, pk_, pv_, pi_, pe_;
#define TOKROW(c_) (((c_) * TC + ps) < CTXL ? (MX + b * CTXL + (dir ? (CTXL - 1 - ((c_) * TC + ps)) : ((c_) * TC + ps))) : (b * SEQ + (dir ? (SEQ - 1 - ((c_) * TC + ps - CTXL)) : ((c_) * TC + ps - CTXL))))
#define PREFETCH(c_) do { const int mr_ = TOKROW(c_); const f16_t* q_ = RKV + (size_t)mr_ * 3072 + ch; \
                    pr_ = *(const u32x2*)q_; pk_ = *(const u32x2*)(q_ + RW); pv_ = *(const u32x2*)(q_ + 2 * RW); \
                    pi_ = *(const u32x2*)(Li + (size_t)mr_ * RW + ch); pe_ = *(const u32x2*)(Le + (size_t)mr_ * RW + ch); } while (0)
#define PREPROC() do {   \
                    const h16x4 hr = __builtin_bit_cast(h16x4, pr_), hk = __builtin_bit_cast(h16x4, pk_), hv = __builtin_bit_cast(h16x4, pv_), hi = __builtin_bit_cast(h16x4, pi_), he = __builtin_bit_cast(h16x4, pe_); \
                    f32x4 k4, kk4, ic4, e4, r4, v4; \
                    _Pragma("unroll") for (int j_ = 0; j_ < 4; ++j_) { k4[j_] = (float)hk[j_]; ic4[j_] = (float)hi[j_]; r4[j_] = (float)hr[j_]; v4[j_] = (float)hv[j_]; e4[j_] = (float)he[j_]; } \
                    kk4 = k4 * kkp; \
                    float ss = (kk4[0] * kk4[0] + kk4[1] * kk4[1]) + (kk4[2] * kk4[2] + kk4[3] * kk4[3]); \
                    ss += dpp_f<DPP_XOR1>(ss); ss += dpp_f<DPP_XOR2>(ss); ss += dpp_f<DPP_HALF_MIRROR>(ss); ss += dpp_f<DPP_MIRROR>(ss); \
                    const float inv = __builtin_amdgcn_rsqf(fmaxf(ss, 1e-24f));        \
                    kk4 = kk4 * inv; \
                    const f32x4 kd4 = k4 * (1.0f + (ic4 - 1.0f) * kap), bb4 = kk4 * ic4; \
                    const int o_ = ps * RS + 4 * kg; \
                    *(LAS f32x4*)(raw + 0 * AS + o_) = e4; *(LAS f32x4*)(raw + 1 * AS + o_) = kk4; *(LAS f32x4*)(raw + 2 * AS + o_) = bb4; \
                    *(LAS f32x4*)(raw + 3 * AS + o_) = kd4; *(LAS f32x4*)(raw + 4 * AS + o_) = r4; *(LAS f32x4*)(raw + 5 * AS + o_) = v4; } while (0)
#define FLUSH(c_) do { const f32x4 y4 = *(const LAS f32x4*)(ybuf + ps * 64 + 4 * kg); u32x2 w_; w_.x = pk_f16(y4[0], y4[1]); w_.y = pk_f16(y4[2], y4[3]); \
                    *(u32x2*)(YSC + (size_t)dir * MX * RW + (size_t)TOKROW(c_) * RW + ch) = w_; } while (0)
                PREFETCH(0);
                PREPROC();
                PREFETCH(1);
                __syncthreads();
                for (int j = -1; j < NSUB; ++j) {
                    const int pb = j & 1, s0 = (j & 1) * 16;
                    if (wave < 4) {
                        if (j >= 0) {
                            f32x4 accX = (f32x4){0.f, 0.f, 0.f, 0.f}; accY = accX;
#pragma unroll
                            for (int kk = 0; kk < 2; ++kk) { const bf16x8 bS = FRAG(SB, LD64, wave * 16, kk);
                                accX = __builtin_amdgcn_mfma_f32_16x16x32_bf16(FRAG(D64(pb, 0), LD64, 0, kk), bS, accX, 0, 0, 0);
                                accY = __builtin_amdgcn_mfma_f32_16x16x32_bf16(bS, FRAG(D64(pb, 1), LD64, 0, kk), accY, 0, 0, 0); }
                            const bf16x8 vB = FRAG(D32(pb, 2), LD32, wave * 16, 0);
                            accX = __builtin_amdgcn_mfma_f32_16x16x32_bf16(FRAG(AMB(pb, 0), LD32, 0, 0), vB, accX, 0, 0, 0);
                            accY = __builtin_amdgcn_mfma_f32_16x16x32_bf16(vB, FRAG(AMB(pb, 1), LD32, 0, 0), accY, 0, 0, 0);
                            { u32x2 w_; w_.x = cvt_pk_bf16(accX[0], accX[1]); w_.y = cvt_pk_bf16(accX[2], accX[3]); *(LAS u32x2*)(XTa + (wave * 16 + fr) * LD32 + fq * 4) = w_; }
                            LDSFENCE();
                            const bf16x8 xB = FRAG(XTa, LD32, wave * 16, 0);
                            const f32x4 accU = __builtin_amdgcn_mfma_f32_16x16x32_bf16(FRAG(AMB(pb, 3), LD32, 0, 0), xB, (f32x4){0.f, 0.f, 0.f, 0.f}, 0, 0, 0);
                            { u32x2 w_; w_.x = cvt_pk_bf16(accU[0], accU[1]); w_.y = cvt_pk_bf16(accU[2], accU[3]); *(LAS u32x2*)(UTa + (wave * 16 + fr) * LD32 + fq * 4) = w_; }
                        }
                    } else if (j + 1 < NSUB) {
                        const int pbn = (j + 1) & 1, s0n = ((j + 1) & 1) * 16, tp = tid - 256, t = tp & 15, k0 = 4 * (tp >> 4);
                        const int ro = (s0n + t) * RS + k0;
                        const f32x4 e4 = *(const LAS f32x4*)(raw + ro), kk4 = *(const LAS f32x4*)(raw + AS + ro), bb4 = *(const LAS f32x4*)(raw + 2 * AS + ro), kd4 = *(const LAS f32x4*)(raw + 3 * AS + ro), r4 = *(const LAS f32x4*)(raw + 4 * AS + ro), v4 = *(const LAS f32x4*)(raw + 5 * AS + ro);
                        f32x4 Pt, Pp, iP, PC;
#pragma unroll
                        for (int q = 0; q < 4; ++q) { float x = e4[q];
                            x += dpp_fz<0x111>(x); x += dpp_fz<0x112>(x); x += dpp_fz<0x114>(x); x += dpp_fz<0x118>(x);
                            const float pt = __expf(-x), sh = dpp_fz<0x111>(pt);
                            Pt[q] = pt; Pp[q] = (t == 0) ? 1.0f : sh; iP[q] = __builtin_amdgcn_rcpf(pt); PC[q] = iP[q] * __shfl(pt, lane | 15); }
                        { u32x2 w_;
                          w_.x = cvt_pk_bf16(-kk4[0] * Pp[0], -kk4[1] * Pp[1]); w_.y = cvt_pk_bf16(-kk4[2] * Pp[2], -kk4[3] * Pp[3]); *(LAS u32x2*)(D64(pbn, 0) + t * LD64 + k0) = w_;
                          w_.x = cvt_pk_bf16(r4[0] * Pt[0], r4[1] * Pt[1]); w_.y = cvt_pk_bf16(r4[2] * Pt[2], r4[3] * Pt[3]); *(LAS u32x2*)(D64(pbn, 1) + t * LD64 + k0) = w_;
                          w_.x = cvt_pk_bf16(bb4[0] * iP[0], bb4[1] * iP[1]); w_.y = cvt_pk_bf16(bb4[2] * iP[2], bb4[3] * iP[3]); *(LAS u32x2*)(D64(pbn, 2) + t * LD64 + k0) = w_;
                          w_.x = cvt_pk_bf16(kd4[0] * iP[0], kd4[1] * iP[1]); w_.y = cvt_pk_bf16(kd4[2] * iP[2], kd4[3] * iP[3]); *(LAS u32x2*)(D64(pbn, 3) + t * LD64 + k0) = w_; }
                        {
                            unsigned own[6];
                            own[0] = cvt_pk_bf16(bb4[0] * PC[0], bb4[1] * PC[1]); own[1] = cvt_pk_bf16(bb4[2] * PC[2], bb4[3] * PC[3]);
                            own[2] = cvt_pk_bf16(kd4[0] * PC[0], kd4[1] * PC[1]); own[3] = cvt_pk_bf16(kd4[2] * PC[2], kd4[3] * PC[3]);
                            own[4] = cvt_pk_bf16(v4[0], v4[1]); own[5] = cvt_pk_bf16(v4[2], v4[3]);
                            const bool ev = (t & 1) == 0;
#pragma unroll
                            for (int q = 0; q < 6; ++q) { const unsigned pt = dpp_u<DPP_XOR1>(own[q]);
                                const unsigned val = ev ? ((own[q] & 0xffffu) | (pt << 16)) : ((pt >> 16) | (own[q] & 0xffff0000u));
                                const int row = k0 + 2 * (q & 1) + (ev ? 0 : 1), col = ev ? t : t - 1;
                                *(LAS unsigned*)(D32(pbn, q >> 1) + row * LD32 + col) = val; }
                        }
                        if (t == 15) *(LAS f32x4*)(P16B(pbn) + k0) = Pt;
                    }
                    if (j >= 2 && (j & 1) == 0 && (j >> 1) - 1 >= CTXL / TC) FLUSH((j >> 1) - 1);
                    __syncthreads();
                    if (wave < 4) {
                        if (j >= 0) {
                            const bf16x8 uB = FRAG(UTa, LD32, wave * 16, 0);
                            accY = __builtin_amdgcn_mfma_f32_16x16x32_bf16(uB, FRAG(AMB(pb, 2), LD32, 0, 0), accY, 0, 0, 0);
                            *(LAS f32x4*)(ybuf + (s0 + fr) * 64 + wave * 16 + fq * 4) = accY;
                            const bf16x8 vA = FRAG(D32(pb, 2), LD32, wave * 16, 0);
#pragma unroll
                            for (int kt = 0; kt < 4; ++kt) {
                                const f32x4 p16 = *(const LAS f32x4*)(P16B(pb) + kt * 16 + fq * 4);
                                accS[kt] = accS[kt] * p16;
                                accS[kt] = __builtin_amdgcn_mfma_f32_16x16x32_bf16(FRAG(D32(pb, 1), LD32, kt * 16, 0), vA, accS[kt], 0, 0, 0);
                                accS[kt] = __builtin_amdgcn_mfma_f32_16x16x32_bf16(FRAG(D32(pb, 0), LD32, kt * 16, 0), uB, accS[kt], 0, 0, 0);
                                u32x2 w_; w_.x = cvt_pk_bf16(accS[kt][0], accS[kt][1]); w_.y = cvt_pk_bf16(accS[kt][2], accS[kt][3]);
                                *(LAS u32x2*)(SB + (wave * 16 + fr) * LD64 + kt * 16 + fq * 4) = w_;
                            }
                        }
                    } else if (j + 1 < NSUB) {
                        const int pbn = (j + 1) & 1, which = wave - 4;
                        const LAS bf16_t* Am = D64(pbn, which < 2 ? 0 : 1); const LAS bf16_t* Bm = D64(pbn, (which & 1) ? 2 : 3);
                        f32x4 a = (f32x4){0.f, 0.f, 0.f, 0.f};
#pragma unroll
                        for (int kk = 0; kk < 2; ++kk) a = __builtin_amdgcn_mfma_f32_16x16x32_bf16(FRAG(Am, LD64, 0, kk), FRAG(Bm, LD64, 0, kk), a, 0, 0, 0);
#pragma unroll
                        for (int rg = 0; rg < 4; ++rg) { const int t = fq * 4 + rg; const bool keep = which < 2 ? (t > fr) : (t >= fr); a[rg] = keep ? a[rg] : 0.f; }
                        if (which != 1) {
                            LAS bf16_t* dst = AMB(pbn, which == 0 ? 0 : (which == 2 ? 1 : 2));
#pragma unroll
                            for (int rg = 0; rg < 4; ++rg) { const float nbv = dpp_f<DPP_XOR1>(a[rg]);
                                if ((fr & 1) == 0) *(LAS unsigned*)(dst + (fq * 4 + rg) * LD32 + fr) = cvt_pk_bf16(a[rg], nbv); }
                        } else {
                            *(LAS f32x4*)(AabT + fr * 16 + fq * 4) = a;
                            LDSFENCE();
                            const int g = (lane >> 3) & 3, c = lane & 7, o = (g == 1 || g == 2) ? 8 : 0;
                            float U[8];
                            { const f32x4 h0 = *(const LAS f32x4*)(AabT + c * 16 + 8), h1 = *(const LAS f32x4*)(AabT + c * 16 + 12);
#pragma unroll
                              for (int r = 0; r < 8; ++r) { const float rh = r < 4 ? h0[r] : h1[r - 4]; U[r] = (g == 2) ? rh : ((r == c) ? 1.0f : 0.0f); } }
#pragma unroll
                            for (int i = 0; i < 7; ++i) {
                                const LAS float* colp = AabT + (o + i) * 16 + o;
                                const f32x4 c0 = *(const LAS f32x4*)colp, c1 = *(const LAS f32x4*)(colp + 4);
#pragma unroll
                                for (int r = i + 1; r < 8; ++r) U[r] += (r < 4 ? c0[r] : c1[r - 4]) * U[i];
                            }
                            if (lane < 24) { LAS float* sc = (g == 0 ? ScT : (g == 1 ? ScT2 : ScM)) + c * 8;
                                *(LAS f32x4*)sc = (f32x4){U[0], U[1], U[2], U[3]}; *(LAS f32x4*)(sc + 4) = (f32x4){U[4], U[5], U[6], U[7]}; }
                            LDSFENCE();
                            const int r21 = lane >> 3;
                            const float t11 = ScT[c * 8 + r21], t22 = ScT2[c * 8 + r21];
                            float t21 = 0.f;
                            { const f32x4 t0 = *(const LAS f32x4*)(ScT + c * 8), t1 = *(const LAS f32x4*)(ScT + c * 8 + 4);
#pragma unroll
                              for (int i = 0; i < 8; ++i) t21 += ScM[i * 8 + r21] * (i < 4 ? t0[i] : t1[i - 4]); }
                            LAS bf16_t* dst = AMB(pbn, 3);
                            const float n11 = dpp_f<DPP_XOR1>(t11), n22 = dpp_f<DPP_XOR1>(t22), n21 = dpp_f<DPP_XOR1>(t21);
                            if ((lane & 1) == 0) {
                                *(LAS unsigned*)(dst + r21 * LD32 + c) = cvt_pk_bf16(t11, n11);
                                *(LAS unsigned*)(dst + (8 + r21) * LD32 + 8 + c) = cvt_pk_bf16(t22, n22);
                                *(LAS unsigned*)(dst + (8 + r21) * LD32 + c) = cvt_pk_bf16(t21, n21);
                            }
                        }
                    }
                    if (j >= 0 && (j & 1) == 0 && (j >> 1) + 1 < NCH) { PREPROC(); if ((j >> 1) + 2 < NCH) PREFETCH((j >> 1) + 2); }
                    __syncthreads();
                }
                FLUSH(NCH - 1);
                __syncthreads();
            }
#undef FRAG
#undef LDSFENCE
#undef TOKROW
#undef PREFETCH
#undef PREPROC
#undef FLUSH
#undef D64
#undef D32
#undef P16B
#undef AMB
        } SEAM(9);

        if (PH_ON(10) && IN(10)) for (int rep_ = 0; rep_ < NREP(10); ++rep_) { if (rep_) xcd_barrier(xbar);
            const f16_t* RKV = (const f16_t*)(ws + WS_R2); const f16_t* L = (const f16_t*)(ws + WS_R1); const f16_t* YSC = (const f16_t*)(ws + WS_YSC);
            const int ch0 = lane * 16;
            float ka[16], rk[16], gng[16], gnb[16];
#pragma unroll
            for (int j = 0; j < 16; ++j) { ka[j] = p.in[I_KA][ch0 + j]; rk[j] = p.in[I_RK][ch0 + j]; gng[j] = p.in[I_GNG][ch0 + j]; gnb[j] = p.in[I_GNB][ch0 + j]; }
            for (int m = gw; m < MX; m += NGW) {
                float y[16], r[16], k[16], v[16], i0[16], i1[16], gt[16], t[8];
#define LD16(dst, ptr) do { h8_to_f(*(const u32x4*)(ptr), t); _Pragma("unroll") for (int j = 0; j < 8; ++j) dst[j] = t[j]; h8_to_f(*(const u32x4*)((ptr) + 8), t); _Pragma("unroll") for (int j = 0; j < 8; ++j) dst[8 + j] = t[j]; } while (0)
                LD16(y, YSC + (size_t)m * RW + ch0); LD16(r, YSC + (size_t)MX * RW + (size_t)m * RW + ch0);
#pragma unroll
                for (int j = 0; j < 16; ++j) y[j] += r[j];
                LD16(r, RKV + (size_t)m * 3072 + ch0); LD16(k, RKV + (size_t)m * 3072 + RW + ch0); LD16(v, RKV + (size_t)m * 3072 + 2 * RW + ch0);
                LD16(i0, L + (size_t)2 * MT * RW + (size_t)m * RW + ch0); LD16(i1, L + (size_t)3 * MT * RW + (size_t)m * RW + ch0); LD16(gt, L + (size_t)4 * MT * RW + (size_t)m * RW + ch0);
#undef LD16
                float s = 0.f, bon = 0.f;
#pragma unroll
                for (int j = 0; j < 16; ++j) { s += y[j]; const float kd = k[j] * (2.0f + (i0[j] + i1[j] - 2.0f) * ka[j]); bon += r[j] * kd * rk[j]; }
                s += dpp_f<DPP_XOR1>(s); s += dpp_f<DPP_XOR2>(s); bon += dpp_f<DPP_XOR1>(bon); bon += dpp_f<DPP_XOR2>(bon);
                const float mean = s * (1.0f / 64.0f); float s2 = 0.f;
#pragma unroll
                for (int j = 0; j < 16; ++j) { y[j] -= mean; s2 += y[j] * y[j]; }
                s2 += dpp_f<DPP_XOR1>(s2); s2 += dpp_f<DPP_XOR2>(s2);
                const float rstd = 1.0f / sqrtf(s2 * (1.0f / 64.0f) + GN_EPS);
                unsigned w[8];
#pragma unroll
                for (int j = 0; j < 16; j += 2) { const float o0 = (y[j] * rstd * gng[j] + gnb[j] + bon * v[j]) * gt[j], o1 = (y[j + 1] * rstd * gng[j + 1] + gnb[j + 1] + bon * v[j + 1]) * gt[j + 1]; w[j >> 1] = cvt_pk_bf16(o0, o1); }
                bf16_t* o = R0 + (size_t)m * D + ch0;
                *(u32x4*)o = (u32x4){w[0], w[1], w[2], w[3]}; *(u32x4*)(o + 8) = (u32x4){w[4], w[5], w[6], w[7]};
            }
        } SEAM(10);
        if (PH_ON(11) && IN(11)) for (int rep_ = 0; rep_ < NREP(11); ++rep_) { if (rep_) xcd_barrier(xbar);
            pg8::Gemm g{R0, (const bf16_t*)(ws + WS_WOUT), MX, D, D, D}; pg8::StaticOrder S; S.init(MX, D, G, bid);
            EpiResid E{Yx, Yc, Yx, Yc, st1, lng, lnb, modv, 5, 1.0f};
            pg8::gemm_phase<EpiResid, pg8::StaticOrder>(lds, g, S, E);
        } SEAM(11);
        if (PH_ON(12) && IN(12)) for (int rep_ = 0; rep_ < NREP(12); ++rep_) { if (rep_) xcd_barrier(xbar); ln_pass<12>(p, lds, ws, Yx, Yc, modv, lng, lnb, st1, st2, R0, gw, NGW, lane, wave); } SEAM(12);
        if (PH_ON(13) && IN(13)) for (int rep_ = 0; rep_ < NREP(13); ++rep_) { if (rep_) xcd_barrier(xbar);
            pg8::Gemm g{R0, (const bf16_t*)(ws + WS_WIB), MX, NWI, D, D}; pg8::StaticOrder S; S.init(MX, NWI, G, bid);
            EpiSwiglu E{(bf16_t*)(ws + WS_R1)};
            pg8::gemm_phase<EpiSwiglu, pg8::StaticOrder>(lds, g, S, E);
        } SEAM(13);
        if (PH_ON(14) && IN(14)) for (int rep_ = 0; rep_ < NREP(14); ++rep_) { if (rep_) xcd_barrier(xbar);
            pg8::Gemm g{(const bf16_t*)(ws + WS_R1), (const bf16_t*)(ws + WS_WOB), MX, D, DFF, DFF}; pg8::StaticOrder S; S.init(MX, D, G, bid);
            EpiResid E{Yx, Yc, Yx, Yc, st2, lng + D, lnb + D, modv, 8, 0.5f};
            pg8::gemm_phase<EpiResid, pg8::StaticOrder>(lds, g, S, E);
        } SEAM(14);
        if (PH_ON(15) && IN(15)) for (int rep_ = 0; rep_ < NREP(15); ++rep_) { if (rep_) xcd_barrier(xbar);
            const float* lg = lng + 2 * D; const float* lb = lnb + 2 * D;
            LAS float* Lg = (LAS float*)lds; LAS float* Lb = Lg + D;
            *(LAS f32x4*)(Lg + tid * 4) = *(const f32x4*)(lg + tid * 4); *(LAS f32x4*)(Lb + tid * 4) = *(const f32x4*)(lb + tid * 4);
            __syncthreads();
            f32x4 nv[8];
#pragma unroll
            for (int q = 0; q < 8; ++q) nv[q] = *(const f32x4*)(Yx + (size_t)gw * D + q * 256 + lane * 4);
            for (int m = gw; m < MX; m += NGW) {
                float* yr = Yx + (size_t)m * D;
                f32x4 v[8]; float s = 0.f;
#pragma unroll
                for (int q = 0; q < 8; ++q) { v[q] = nv[q]; s += (v[q][0] + v[q][1]) + (v[q][2] + v[q][3]); }
                { const int mn = m + NGW < MX ? m + NGW : m;
#pragma unroll
                  for (int q = 0; q < 8; ++q) nv[q] = *(const f32x4*)(Yx + (size_t)mn * D + q * 256 + lane * 4); }
                const float mean = wave_sum(s) * (1.0f / D); float s2 = 0.f;
#pragma unroll
                for (int q = 0; q < 8; ++q) { v[q] = v[q] - mean; s2 += (v[q][0] * v[q][0] + v[q][1] * v[q][1]) + (v[q][2] * v[q][2] + v[q][3] * v[q][3]); }
                const float rstd = 1.0f / sqrtf(wave_sum(s2) * (1.0f / D) + LN_EPS);
                f32x4 g8[8], b8[8];
#pragma unroll
                for (int q = 0; q < 8; ++q) { const int c = q * 256 + lane * 4; g8[q] = *(const LAS f32x4*)(Lg + c); b8[q] = *(const LAS f32x4*)(Lb + c); }
#pragma unroll
                for (int q = 0; q < 8; ++q) { const int c = q * 256 + lane * 4; *(f32x4*)(yr + c) = v[q] * rstd * g8[q] + b8[q]; }
            }
        } SEAM(15);
#undef IN
#undef SEAM
}

extern "C" void kernel_launch(void* const* d_in, const int* in_sizes, int n_in, void* d_out, int out_size, void* d_ws, size_t ws_size, hipStream_t stream) {
    static int grid = 0;
    if (grid == 0) {
        int dev = 0, cus = 0, per_cu = 0;
        hipGetDevice(&dev);
        hipDeviceGetAttribute(&cus, hipDeviceAttributeMultiprocessorCount, dev);
        hipFuncSetAttribute((const void*)fwd_megakernel, hipFuncAttributeMaxDynamicSharedMemorySize, LDS_BYTES);
        hipOccupancyMaxActiveBlocksPerMultiprocessor(&per_cu, (const void*)fwd_megakernel, 512, LDS_BYTES);
        if (per_cu < 1) per_cu = 1;
        grid = cus * per_cu;
        if (ws_size < WS_END) fprintf(stderr, "kernel_launch: workspace too small: %zu < %zu\n", ws_size, (size_t)WS_END);
    }
    (void)hipMemsetAsync(d_ws, 0, 16384, stream);
    Params p{};
    for (int i = 0; i < 29; ++i) p.in[i] = (const float*)d_in[i];
    p.out = (float*)d_out; p.ws = (unsigned char*)d_ws;
#if SPLIT_LAUNCH
    for (int ph = 0; ph < 16; ++ph) {
        p.ph_lo = ph; p.ph_hi = ph + 1;
        hipLaunchKernelGGL(fwd_megakernel, dim3(grid), dim3(512), LDS_BYTES, stream, p);
    }
#else
    p.ph_lo = 0; p.ph_hi = 16;
    void* args[] = {&p};
    hipError_t e = hipLaunchCooperativeKernel((const void*)fwd_megakernel, dim3(grid), dim3(512), args, LDS_BYTES, stream);
    if (e != hipSuccess) fprintf(stderr, "cooperative launch failed: %s (grid %d)\n", hipGetErrorString(e), grid);
#endif
}
```

```cpp
#include <hip/hip_runtime.h>
#include <hip/hip_cooperative_groups.h>
#include <cstdio>
namespace cg = cooperative_groups;

#ifndef SPLIT_LAUNCH
#define SPLIT_LAUNCH 0
#endif

#ifndef PHMASK
#define PHMASK 0xFFFF
#endif
#define PH_ON(n) (((PHMASK) >> (n)) & 1)
#ifndef DUPMASK
#define DUPMASK 0
#endif
#define NREP(n) ((((DUPMASK) >> (n)) & 1) ? 2 : 1)
#define LAS __attribute__((address_space(3)))
typedef unsigned short bf16_t;
typedef unsigned short f16_t;
typedef short bf16x8 __attribute__((ext_vector_type(8)));
typedef float f32x4 __attribute__((ext_vector_type(4)));
typedef float f32x2 __attribute__((ext_vector_type(2)));
typedef unsigned u32x4 __attribute__((ext_vector_type(4)));
typedef unsigned u32x2 __attribute__((ext_vector_type(2)));
typedef _Float16 h16x2 __attribute__((ext_vector_type(2)));
typedef _Float16 h16x4 __attribute__((ext_vector_type(4)));
typedef _Float16 h16x8 __attribute__((ext_vector_type(8)));

constexpr int D = 2048, NB = 8, SEQ = 4096, CTXL = 256;
constexpr int MX = NB * SEQ, MC = NB * CTXL, MT = MX + MC;
constexpr int DFF = 5632, NWI = 2 * DFF, INW = 5376, RIN = 3328, RW = 1024, NH = 16, HD = 64;
constexpr int MODW = 9 * D;
constexpr int NLORA = 5 * RW, KLORA = 256;
constexpr float ALPHA = 1.189207115002721f;
constexpr float LN_EPS = 1e-5f, GN_EPS = 64e-5f;

constexpr size_t MiB = 1u << 20;
constexpr size_t WS_MODV = 1 * MiB;
constexpr size_t WS_ST1 = 2 * MiB;
constexpr size_t WS_ST2 = 2 * MiB + 512 * 1024;
constexpr size_t WS_WSB = 3 * MiB;
constexpr size_t WS_LORAB = 4 * MiB;
constexpr size_t WS_LBIAS = 6 * MiB + 512 * 1024;
constexpr size_t WS_WIN = 7 * MiB;
constexpr size_t WS_WOUT = 28 * MiB;
constexpr size_t WS_WIA = 36 * MiB;
constexpr size_t WS_WOA = 80 * MiB;
constexpr size_t WS_Y1C = 102 * MiB;
constexpr size_t WS_R0 = 118 * MiB;
constexpr size_t WS_R1 = 254 * MiB;
constexpr size_t WS_ALORA = WS_R1 + (size_t)MT * INW * 2;
constexpr size_t WS_R2 = 628 * MiB;
constexpr size_t WS_PART = WS_R2;
constexpr size_t WS_VT = WS_R2 + (size_t)MT * 3072 * 2;
constexpr size_t WS_YSC = WS_VT;
constexpr size_t WS_WIB = WS_R2;
constexpr size_t WS_WOB = WS_R2 + 44 * MiB;
constexpr size_t WS_END = WS_YSC + (size_t)2 * MX * RW * 2;
static_assert(WS_END <= 1024 * MiB, "ws map");
static_assert(WS_R1 + (size_t)MT * DFF * 2 <= WS_R2, "R1");
static_assert(WS_ALORA + (size_t)MT * 256 * 2 <= WS_R2, "alora");

constexpr int LDS_BYTES = 143360;

typedef __bf16 bf16v2 __attribute__((ext_vector_type(2)));
__device__ __forceinline__ unsigned cvt_pk_bf16(float lo, float hi) { const f32x2 v = (f32x2){lo, hi}; const bf16v2 b = __builtin_convertvector(v, bf16v2); return __builtin_bit_cast(unsigned, b); }
__device__ __forceinline__ unsigned pk_f16(float lo, float hi) { h16x2 v; v.x = (_Float16)lo; v.y = (_Float16)hi; return __builtin_bit_cast(unsigned, v); }
__device__ __forceinline__ float sigm(float x) { return __builtin_amdgcn_rcpf(1.0f + __expf(-x)); }
__device__ __forceinline__ float siluf(float x) { return x * sigm(x); }
__device__ __forceinline__ float gelu_t(float x) { return x * sigm(1.5957691216057308f * (x + 0.044715f * x * x * x)); }
__device__ __forceinline__ float tanh_f(float x) { return 2.0f * sigm(2.0f * x) - 1.0f; }
template <int CTRL> __device__ __forceinline__ float dpp_f(float x) {
    return __builtin_bit_cast(float, __builtin_amdgcn_update_dpp(0, __builtin_bit_cast(int, x), CTRL, 0xF, 0xF, false));
}
template <int CTRL> __device__ __forceinline__ float dpp_fz(float x) {
    return __builtin_bit_cast(float, __builtin_amdgcn_update_dpp(0, __builtin_bit_cast(int, x), CTRL, 0xF, 0xF, true));
}
template <int CTRL> __device__ __forceinline__ unsigned dpp_u(unsigned x) {
    return (unsigned)__builtin_amdgcn_update_dpp(0, (int)x, CTRL, 0xF, 0xF, false);
}
constexpr int DPP_XOR1 = 0xB1, DPP_XOR2 = 0x4E, DPP_HALF_MIRROR = 0x141, DPP_MIRROR = 0x140;
__device__ __forceinline__ float wave_sum(float v) {
    v += dpp_f<DPP_XOR1>(v); v += dpp_f<DPP_XOR2>(v); v += dpp_f<DPP_HALF_MIRROR>(v); v += dpp_f<DPP_MIRROR>(v);
    v += __shfl_xor(v, 16); v += __shfl_xor(v, 32);
    return v;
}
__device__ __forceinline__ void h8_to_f(const u32x4 v, float* f) {
    const h16x8 h = __builtin_bit_cast(h16x8, v);
#pragma unroll
    for (int j = 0; j < 8; ++j) f[j] = (float)h[j];
}

namespace pg8 {
constexpr int BM = 256, BK = 64, HALF = 128, HTB = HALF * BK * 2, STAGE_BYTES = 8 * HTB, NXCD = 8, WGM = 8;
__host__ __device__ __forceinline__ int lds_byte(int r, int c) { const int st = (r >> 4) * 2 + (c >> 5), rr = r & 15, cc = c & 31, ob = rr * 64 + cc * 2; return st * 1024 + (ob ^ (((ob >> 9) & 1) << 5)); }
__host__ __device__ __forceinline__ void stage_rc(int b, int& R, int& C) { const int st = b / 1024, sb = b % 1024, swz = sb ^ (((sb >> 9) & 1) << 5); R = (st >> 1) * 16 + swz / 64; C = (st & 1) * 32 + (swz % 64) / 2; }
__host__ __device__ __forceinline__ int perm32(int rho) { const int n = rho >> 4, i = rho & 15; return 8 * (i >> 2) + 4 * n + (i & 3); }

struct Unit { int pm, pn, ks; };
struct Gemm { const bf16_t* A; const bf16_t* Bt; int M, N, K, ld; };

struct StaticOrder {
    static constexpr bool OPAQUE_K = false;
    int nM, nN, nwg, G, c;
    __device__ void init(int M, int N, int G_, int c_) { nM = M / BM; nN = N / BM; nwg = nM * nN; G = G_; c = c_; }
    __device__ bool next(int i, Unit& u) const {
        const long L = (long)i * G + c; if (L >= nwg) return false;
        int wgid = (int)L; { const int q = nwg / NXCD, r = nwg % NXCD, xcd = wgid % NXCD, off = wgid / NXCD; wgid = (xcd < r ? xcd * (q + 1) : r * (q + 1) + (xcd - r) * q) + off; }
        const int nig = WGM * nN, gid = wgid / nig, fm = gid * WGM, gsz = (nM - fm) < WGM ? (nM - fm) : WGM;
        u.pm = fm + ((wgid % nig) % gsz); u.pn = (wgid % nig) / gsz; u.ks = 0; return true;
    }
};
struct RectOrder {
    static constexpr bool OPAQUE_K = false;
    StaticOrder so; int n1, n2m, n2n, pm0;
    __device__ void init(int M1, int N1, int n2m_, int n2n_, int G_, int c_) { so.init(M1, N1, G_, c_); n1 = so.nwg; n2m = n2m_; n2n = n2n_; pm0 = so.nM; }
    __device__ bool next(int i, Unit& u) const {
        const long L = (long)i * so.G + so.c;
        if (L < n1) return so.next(i, u);
        const int idx = (int)(L - n1); if (idx >= n2m * n2n) return false;
        u.pm = pm0 + idx % n2m; u.pn = idx / n2m; u.ks = 0; return true;
    }
};
struct LoraOrder {
    static constexpr bool OPAQUE_K = true;
    StaticOrder so;
    __device__ bool next(int i, Unit& u) const { if (!so.next(i, u)) return false; u.ks = u.pn >= 16 ? 1 : 0; return true; }
};
struct SplitOrder {
    static constexpr bool OPAQUE_K = false;
    int nm, nn, ns, pm0, G, c;
    __device__ bool next(int i, Unit& u) const {
        const long L = (long)i * G + c; if (L >= (long)nm * nn * ns) return false;
        const int idx = (int)L; u.ks = idx % ns; const int tile = idx / ns; u.pm = pm0 + tile % nm; u.pn = tile / nm; return true;
    }
};

template <class Epi, class Order>
__device__ __forceinline__ void gemm_phase(LAS unsigned char* lds, const Gemm g, const Order& S, const Epi& E) {
    const int tid = threadIdx.x, wid = __builtin_amdgcn_readfirstlane(tid >> 6), lane = tid & 63, wr = wid >> 2, wc = wid & 3, fr = lane & 15, fq = lane >> 4;
    int K = g.K; if (Order::OPAQUE_K) asm volatile("" : "+s"(K));
    const int nt = K / BK;
    unsigned voffA[2], voffB[2];
#pragma unroll
    for (int i = 0; i < 2; ++i) { int R, C; stage_rc(tid * 16 + i * 8192, R, C); const int Rb = Epi::PERM ? ((R & ~31) + perm32(R & 31)) : R;
        voffA[i] = (unsigned)(R * g.ld + C) * 2u; voffB[i] = (unsigned)(Rb * g.ld + C) * 2u; }
    const size_t kstep = (size_t)(BK * 2);
    const size_t hstep = (size_t)HALF * g.ld * 2;
    const size_t sstep = (size_t)K * 2;
    const size_t tstep = 2 * hstep;
    const unsigned ldsw = (unsigned)wid * 1024u;
    const int aoff = lds_byte(wr * 64 + fr, fq * 8), boff = lds_byte(wc * 32 + fr, fq * 8);
#define PG8_SA(b, h) (((b) * 2 + (h)) * HTB)
#define PG8_SB(b, h) ((4 + (b) * 2 + (h)) * HTB)
#define PG8_STAGE(bufoff, gbase, voff) do { _Pragma("unroll") for (int _i = 0; _i < 2; ++_i) \
        __builtin_amdgcn_global_load_lds((const unsigned*)((const char*)(gbase) + (voff)[_i]), (LAS unsigned*)(lds + (bufoff) + ldsw + _i * 8192), 16, 0, 0); } while (0)
#define PG8_LDA(dst, b, h) do { _Pragma("unroll") for (int m = 0; m < 4; ++m) _Pragma("unroll") for (int k = 0; k < 2; ++k) dst[m][k] = *(const LAS bf16x8*)(lds + PG8_SA(b, h) + aoff + m * 2048 + k * 1024); } while (0)
#define PG8_LDB(dst, b, h) do { _Pragma("unroll") for (int n = 0; n < 2; ++n) _Pragma("unroll") for (int k = 0; k < 2; ++k) dst[n][k] = *(const LAS bf16x8*)(lds + PG8_SB(b, h) + boff + n * 2048 + k * 1024); } while (0)
#define PG8_MMA(ai, bj, At, Bt) do { __builtin_amdgcn_s_setprio(1); _Pragma("unroll") for (int m = 0; m < 4; ++m) _Pragma("unroll") for (int n = 0; n < 2; ++n) _Pragma("unroll") for (int k = 0; k < 2; ++k) \
        acc[ai][bj][m][n] = __builtin_amdgcn_mfma_f32_16x16x32_bf16(Bt[n][k], At[m][k], acc[ai][bj][m][n], 0, 0, 0); __builtin_amdgcn_s_setprio(0); } while (0)
#define PG8_WAIT_V(n) asm volatile("s_waitcnt vmcnt(" #n ")" ::: "memory")
#define PG8_WAIT_L(n) asm volatile("s_waitcnt lgkmcnt(" #n ")" ::: "memory")
#define PG8_BAR __builtin_amdgcn_s_barrier()
#define PG8_SCHED __builtin_amdgcn_sched_barrier(0)
    Unit cur, nxt; int ui = 0;
    if (!S.next(0, cur)) return;
    f32x4 acc[2][2][4][2];
#pragma unroll
    for (int a = 0; a < 2; ++a)
#pragma unroll
        for (int b = 0; b < 2; ++b)
#pragma unroll
            for (int m = 0; m < 4; ++m)
#pragma unroll
                for (int n = 0; n < 2; ++n) acc[a][b][m][n] = (f32x4){0.f, 0.f, 0.f, 0.f};
    bf16x8 At[4][2], B0[2][2], B1[2][2];
    const char* cA = (const char*)g.A + (size_t)cur.pm * tstep + (size_t)cur.ks * sstep; const char* cB = (const char*)g.Bt + (size_t)cur.pn * tstep + (size_t)cur.ks * sstep;
    PG8_STAGE(PG8_SB(0, 0), cB, voffB); PG8_STAGE(PG8_SA(0, 0), cA, voffA); PG8_STAGE(PG8_SB(0, 1), cB + hstep, voffB); PG8_STAGE(PG8_SA(0, 1), cA + hstep, voffA);
    if (wr == 1) PG8_BAR;
    PG8_WAIT_V(4); PG8_BAR;
    PG8_STAGE(PG8_SB(1, 0), cB + kstep, voffB); PG8_STAGE(PG8_SA(1, 0), cA + kstep, voffA); PG8_STAGE(PG8_SB(1, 1), cB + hstep + kstep, voffB);
    PG8_WAIT_V(6); PG8_BAR;
    for (;;) {
        const bool has_next = S.next(ui + 1, nxt);
        const char* nA = has_next ? (const char*)g.A + (size_t)nxt.pm * tstep + (size_t)nxt.ks * sstep : cA; const char* nB = has_next ? (const char*)g.Bt + (size_t)nxt.pn * tstep + (size_t)nxt.ks * sstep : cB;
#pragma nounroll
        for (int t = 0; t < nt; t += 2) {
            const bool last = (t == nt - 2);
            const char* a1 = cA + (size_t)(t + 1) * kstep;
            const char* a2 = last ? nA : cA + (size_t)(t + 2) * kstep; const char* b2 = last ? nB : cB + (size_t)(t + 2) * kstep;
            const char* a3 = a2 + kstep; const char* b3 = b2 + kstep;
            PG8_LDB(B0, 0, 0); PG8_SCHED; PG8_LDA(At, 0, 0); PG8_STAGE(PG8_SA(1, 1), a1 + hstep, voffA);
            PG8_WAIT_L(8); PG8_BAR; PG8_WAIT_L(0); PG8_MMA(0, 0, At, B0); PG8_BAR; PG8_SCHED;
            PG8_LDB(B1, 0, 1); PG8_STAGE(PG8_SB(0, 0), b2, voffB);
            PG8_BAR; PG8_WAIT_L(0); PG8_MMA(0, 1, At, B1); PG8_BAR;
            PG8_LDA(At, 0, 1); PG8_STAGE(PG8_SA(0, 0), a2, voffA);
            PG8_BAR; PG8_WAIT_L(0); PG8_MMA(1, 0, At, B0); PG8_BAR; PG8_SCHED;
            PG8_STAGE(PG8_SB(0, 1), b2 + hstep, voffB);
            PG8_WAIT_V(6); PG8_BAR; PG8_MMA(1, 1, At, B1); PG8_BAR;
            PG8_LDB(B0, 1, 0); PG8_SCHED; PG8_LDA(At, 1, 0); PG8_STAGE(PG8_SA(0, 1), a2 + hstep, voffA);
            PG8_WAIT_L(8); PG8_BAR; PG8_WAIT_L(0); PG8_MMA(0, 0, At, B0); PG8_BAR; PG8_SCHED;
            PG8_LDB(B1, 1, 1); PG8_STAGE(PG8_SB(1, 0), b3, voffB);
            PG8_BAR; PG8_WAIT_L(0); PG8_MMA(0, 1, At, B1); PG8_BAR;
            PG8_LDA(At, 1, 1); PG8_STAGE(PG8_SA(1, 0), a3, voffA);
            PG8_BAR; PG8_WAIT_L(0); PG8_MMA(1, 0, At, B0); PG8_BAR; PG8_SCHED;
            PG8_STAGE(PG8_SB(1, 1), b3 + hstep, voffB);
            PG8_WAIT_V(6); PG8_BAR; PG8_MMA(1, 1, At, B1); PG8_BAR;
        }
        E(acc, cur, wr, wc, fr, fq);
        if (!has_next) break;
#pragma unroll
        for (int a = 0; a < 2; ++a)
#pragma unroll
            for (int b = 0; b < 2; ++b)
#pragma unroll
                for (int m = 0; m < 4; ++m)
#pragma unroll
                    for (int n = 0; n < 2; ++n) acc[a][b][m][n] = (f32x4){0.f, 0.f, 0.f, 0.f};
        cur = nxt; cA = nA; cB = nB; ++ui;
    }
    PG8_WAIT_V(0);
    if (wr == 0) PG8_BAR;
    PG8_BAR;
#undef PG8_SA
#undef PG8_SB
#undef PG8_STAGE
#undef PG8_LDA
#undef PG8_LDB
#undef PG8_MMA
#undef PG8_WAIT_V
#undef PG8_WAIT_L
#undef PG8_BAR
#undef PG8_SCHED
}
}

struct EpiSwiglu {
    static constexpr bool PERM = true;
    bf16_t* O;
    __device__ __forceinline__ void operator()(const f32x4 (&acc)[2][2][4][2], const pg8::Unit& u, int wr, int wc, int fr, int fq) const {
        const int row0 = u.pm * 256 + wr * 64 + fr, col0 = u.pn * 128 + wc * 32 + 8 * fq;
#pragma unroll
        for (int ai = 0; ai < 2; ++ai)
#pragma unroll
            for (int m = 0; m < 4; ++m) {
                bf16_t* rowp = O + (size_t)(row0 + ai * 128 + m * 16) * DFF + col0;
                const f32x4 g0 = acc[ai][0][m][0], g1 = acc[ai][0][m][1], u0 = acc[ai][1][m][0], u1 = acc[ai][1][m][1];
                u32x4 w;
                w.x = cvt_pk_bf16(siluf(g0[0]) * u0[0], siluf(g0[1]) * u0[1]); w.y = cvt_pk_bf16(siluf(g0[2]) * u0[2], siluf(g0[3]) * u0[3]);
                w.z = cvt_pk_bf16(siluf(g1[0]) * u1[0], siluf(g1[1]) * u1[1]); w.w = cvt_pk_bf16(siluf(g1[2]) * u1[2], siluf(g1[3]) * u1[3]);
                *(u32x4*)rowp = w;
            }
    }
};
struct EpiF16 {
    static constexpr bool PERM = true;
    f16_t* O; int ldc;
    __device__ __forceinline__ void operator()(const f32x4 (&acc)[2][2][4][2], const pg8::Unit& u, int wr, int wc, int fr, int fq) const {
        const int row0 = u.pm * 256 + wr * 64 + fr, col0 = u.pn * 256 + wc * 32 + 8 * fq;
#pragma unroll
        for (int ai = 0; ai < 2; ++ai)
#pragma unroll
            for (int m = 0; m < 4; ++m) {
                f16_t* rowp = O + (size_t)(row0 + ai * 128 + m * 16) * ldc + col0;
#pragma unroll
                for (int bj = 0; bj < 2; ++bj) { const f32x4 v0 = acc[ai][bj][m][0], v1 = acc[ai][bj][m][1];
                    u32x4 w; w.x = pk_f16(v0[0], v0[1]); w.y = pk_f16(v0[2], v0[3]); w.z = pk_f16(v1[0], v1[1]); w.w = pk_f16(v1[2], v1[3]);
                    *(u32x4*)(rowp + bj * 128) = w; }
            }
    }
};
struct EpiLora {
    static constexpr bool PERM = true;
    f16_t* L; const float* bias;
    __device__ __forceinline__ void operator()(const f32x4 (&acc)[2][2][4][2], const pg8::Unit& u, int wr, int wc, int fr, int fq) const {
        const int reg = u.pn >> 2;
        const int row0 = u.pm * 256 + wr * 64 + fr, cc0 = (u.pn & 3) * 256 + wc * 32 + 8 * fq;
        f16_t* base = L + (size_t)reg * MT * RW + (size_t)row0 * RW + cc0;
        const float* bp = bias + reg * RW + cc0;
        const float sc = reg < 2 ? 0.6065306597126334f : 1.0f;
        const bool act = reg < 4;
        f32x4 bva[2][2];
#pragma unroll
        for (int bj = 0; bj < 2; ++bj)
#pragma unroll
            for (int n = 0; n < 2; ++n) bva[bj][n] = *(const f32x4*)(bp + bj * 128 + 4 * n);
#pragma unroll
        for (int bj = 0; bj < 2; ++bj)
#pragma unroll
            for (int n = 0; n < 2; ++n) {
                const f32x4 bv = bva[bj][n];
#pragma unroll
                for (int ai = 0; ai < 2; ++ai)
#pragma unroll
                    for (int m = 0; m < 4; ++m) {
                        f32x4 v = acc[ai][bj][m][n] + bv;
#pragma unroll
                        for (int j = 0; j < 4; ++j) { const float sg = sc * sigm(v[j]); v[j] = act ? sg : v[j]; }
                        u32x2 w; w.x = pk_f16(v[0], v[1]); w.y = pk_f16(v[2], v[3]);
                        *(u32x2*)(base + (size_t)(ai * 128 + m * 16) * RW + bj * 128 + 4 * n) = w;
                    }
            }
    }
};
struct EpiPartial {
    static constexpr bool PERM = false;
    float* part;
    __device__ __forceinline__ void operator()(const f32x4 (&acc)[2][2][4][2], const pg8::Unit& u, int wr, int wc, int fr, int fq) const {
        float* base = part + (size_t)u.ks * MC * D + (size_t)((u.pm - MX / 256) * 256 + wr * 64 + fr) * D + u.pn * 256 + wc * 32 + 4 * fq;
#pragma unroll
        for (int ai = 0; ai < 2; ++ai)
#pragma unroll
            for (int m = 0; m < 4; ++m)
#pragma unroll
                for (int bj = 0; bj < 2; ++bj)
#pragma unroll
                    for (int n = 0; n < 2; ++n) *(f32x4*)(base + (size_t)(ai * 128 + m * 16) * D + bj * 128 + n * 16) = acc[ai][bj][m][n];
    }
};
struct EpiResid {
    static constexpr bool PERM = false;
    const float* Xx; const float* Xc; float* Yx; float* Yc;
    const f32x2* stats; const float* lg; const float* lb;
    const float* modv; int gslot; float gscale;
    __device__ __forceinline__ void operator()(const f32x4 (&acc)[2][2][4][2], const pg8::Unit& u, int wr, int wc, int fr, int fq) const {
        const bool isx = u.pm < (MX / 256);
        const int mr = isx ? (u.pm >> 4) : 8;
        const float* gate = modv + (size_t)mr * MODW + gslot * D;
        const int lrow0 = (isx ? u.pm : u.pm - MX / 256) * 256 + wr * 64 + fr;
        const float* src = isx ? Xx : Xc; float* dst = isx ? Yx : Yc;
        const int grow0 = u.pm * 256 + wr * 64 + fr;
        f32x2 stv[2][4];
#pragma unroll
        for (int ai = 0; ai < 2; ++ai)
#pragma unroll
            for (int m = 0; m < 4; ++m) stv[ai][m] = stats ? stats[grow0 + ai * 128 + m * 16] : (f32x2){0.f, 1.f};
#pragma unroll
        for (int bj = 0; bj < 2; ++bj)
#pragma unroll
            for (int n = 0; n < 2; ++n) {
                const int col = u.pn * 256 + bj * 128 + wc * 32 + n * 16 + 4 * fq;
                const f32x4 gv = *(const f32x4*)(gate + col) * gscale;
                f32x4 lgv = (f32x4){1.f, 1.f, 1.f, 1.f}, lbv = (f32x4){0.f, 0.f, 0.f, 0.f};
                if (stats) { lgv = *(const f32x4*)(lg + col); lbv = *(const f32x4*)(lb + col); }
                f32x4 xv[2][4];
#pragma unroll
                for (int ai = 0; ai < 2; ++ai)
#pragma unroll
                    for (int m = 0; m < 4; ++m) xv[ai][m] = *(const f32x4*)(src + (size_t)(lrow0 + ai * 128 + m * 16) * D + col);
#pragma unroll
                for (int ai = 0; ai < 2; ++ai)
#pragma unroll
                    for (int m = 0; m < 4; ++m) {
                        const size_t off = (size_t)(lrow0 + ai * 128 + m * 16) * D + col;
                        f32x4 x = xv[ai][m];
                        if (stats) x = (x - stv[ai][m].x) * stv[ai][m].y * lgv + lbv;
                        *(f32x4*)(dst + off) = ALPHA * x + gv * acc[ai][bj][m][n];
                    }
            }
    }
};

#define XB_TMO      128
#define XB_XCNT(j)  (256  + 64 * (j))
#define XB_XSUB(j)  (1280 + 64 * (j))
#define XB_XGEN(j)  (2304 + 64 * (j))
#define XB_TOP      3328
#define XB_TOPGEN   3392
#define XCD_BAR_WORDS 3456
#define XB_SPIN_CAP (1u << 18)

__device__ __forceinline__ unsigned xb_ld(unsigned* p)              { return __hip_atomic_load(p, __ATOMIC_RELAXED, __HIP_MEMORY_SCOPE_AGENT); }
__device__ __forceinline__ unsigned xb_add(unsigned* p, unsigned v) { return __hip_atomic_fetch_add(p, v, __ATOMIC_RELAXED, __HIP_MEMORY_SCOPE_AGENT); }
__device__ __forceinline__ unsigned xb_xcc_id() { return (unsigned)__builtin_amdgcn_s_getreg((3 << 11) | 20) & 0xFu; }
#define XB_SPIN(cond, bar) do { unsigned _sp = 0; while (cond) { __builtin_amdgcn_s_sleep(1); \
    if ((++_sp & 255u) == 0u) { if (xb_ld(&(bar)[XB_TMO])) break; if (_sp > XB_SPIN_CAP) { atomicAdd(&(bar)[XB_TMO], 1u); break; } } } } while (0)

struct XcdBarrier {
    unsigned* bar; unsigned x;
    volatile LAS unsigned* st;
};

__device__ __forceinline__ XcdBarrier xcd_barrier_post(unsigned* bar, volatile LAS unsigned* st) {
    XcdBarrier b; b.bar = bar; b.x = xb_xcc_id(); b.st = st;
    if (threadIdx.x == 0) (void)xb_add(&bar[XB_XCNT(b.x)], 1u);
    return b;
}
__device__ __forceinline__ void xcd_barrier_complete(unsigned* bar, unsigned x, unsigned& nloc, unsigned& nx) {
    const unsigned G = gridDim.x * gridDim.y * gridDim.z;
    unsigned sum, cnt, mine, sp = 0u;
    for (;;) {
        sum = 0u; cnt = 0u; mine = 0u;
#pragma unroll
        for (unsigned j = 0; j < 16; ++j) { const unsigned c = xb_ld(&bar[XB_XCNT(j)]); sum += c; cnt += (c > 0u) ? 1u : 0u; mine = (j == x) ? c : mine; }
        if (sum == G) break;
        __builtin_amdgcn_s_sleep(1);
        if ((++sp & 255u) == 0u) { if (xb_ld(&bar[XB_TMO])) break; if (sp > XB_SPIN_CAP) { atomicAdd(&bar[XB_TMO], 1u); break; } }
    }
    nloc = mine > 0u ? mine : 1u; nx = cnt > 0u ? cnt : 1u;
}

__device__ __forceinline__ void xcd_barrier(const XcdBarrier& b) {
    asm volatile("s_waitcnt vmcnt(0)" ::: "memory");
    __syncthreads();
    if (threadIdx.x == 0) {
        unsigned* bar = b.bar;
        __builtin_amdgcn_s_waitcnt(0);
        unsigned nloc = b.st[0], nx = b.st[1];
        if (nloc == 0u) { xcd_barrier_complete(bar, b.x, nloc, nx); b.st[0] = nloc; b.st[1] = nx; }
        const unsigned old = xb_add(&bar[XB_XSUB(b.x)], 1u);
        const unsigned gen = old / nloc;
        if (old + 1u == (gen + 1u) * nloc) {
            __builtin_amdgcn_fence(__ATOMIC_RELEASE, "agent");
            asm volatile("s_waitcnt vmcnt(0)" ::: "memory");
            const unsigned og = xb_add(&bar[XB_TOP], 1u);
            const unsigned tg = og / nx;
            if (og + 1u == (tg + 1u) * nx) xb_add(&bar[XB_TOPGEN], 1u);
            else XB_SPIN(xb_ld(&bar[XB_TOPGEN]) == tg, bar);
            __builtin_amdgcn_fence(__ATOMIC_ACQUIRE, "agent");
            xb_add(&bar[XB_XGEN(b.x)], 1u);
            asm volatile("s_waitcnt vmcnt(0)" ::: "memory");
        } else {
            XB_SPIN(xb_ld(&bar[XB_XGEN(b.x)]) == gen, bar);
            __builtin_amdgcn_fence(__ATOMIC_ACQUIRE, "agent");
            asm volatile("s_waitcnt vmcnt(0)" ::: "memory");
        }
    }
    __syncthreads();
}

struct Params { const float* in[29]; float* out; unsigned char* ws; int ph_lo, ph_hi; };
enum { I_X = 0, I_C, I_CTX, I_CCTX, I_WADA, I_BADA, I_LNG, I_LNB, I_WIA, I_WOA, I_WIB, I_WOB, I_WIN, I_MU, I_W0, I_WUP, I_A0, I_AUP, I_GUP, I_KK, I_KA, I_RK, I_GNG, I_GNB, I_GMG, I_GMB, I_GMWS, I_GMBS, I_WOUT };

template <bool SWI>
__device__ __forceinline__ void transpose_item(const float* W, int K, int N, bf16_t* WT, LAS float* scr, int item, int lane) {
    const int nblk = N / 32, kb = item / nblk, nb = item % nblk, k0 = 64 * kb, n0 = 32 * nb;
    float wv[32];
#pragma unroll
    for (int i = 0; i < 32; ++i) wv[i] = __builtin_nontemporal_load(W + (size_t)(k0 + 2 * i + (lane >> 5)) * N + n0 + (lane & 31));
#pragma unroll
    for (int i = 0; i < 32; ++i) scr[(2 * i + (lane >> 5)) * 33 + (lane & 31)] = wv[i];
    asm volatile("s_waitcnt lgkmcnt(0)" ::: "memory");
    int r0 = n0;
    if (SWI) { const int bj = n0 / DFF, j = n0 - bj * DFF; r0 = (j >> 7) * 256 + bj * 128 + (j & 127); }
    const int c = lane & 7;
#pragma unroll
    for (int j = 0; j < 4; ++j) { const int n = (lane >> 3) + 8 * j; const LAS float* s = scr + (8 * c) * 33 + n;
        u32x4 o; o.x = cvt_pk_bf16(s[0 * 33], s[1 * 33]); o.y = cvt_pk_bf16(s[2 * 33], s[3 * 33]); o.z = cvt_pk_bf16(s[4 * 33], s[5 * 33]); o.w = cvt_pk_bf16(s[6 * 33], s[7 * 33]);
        *(u32x4*)(WT + (size_t)(r0 + n) * K + k0 + 8 * c) = o; }
    asm volatile("s_waitcnt lgkmcnt(0)" ::: "memory");
}

struct TrItem { const float* W; bf16_t* WT; int K, N, k0, n0, r0; };
__device__ __forceinline__ TrItem tr_decode(const Params& p, unsigned char* ws, int it) {
    constexpr int I_1 = (D / 64) * (NWI / 32);
    const bool first = it < I_1; TrItem t;
    t.W = first ? p.in[I_WIB] : p.in[I_WOB]; t.WT = (bf16_t*)(ws + (first ? WS_WIB : WS_WOB)); t.K = first ? D : DFF; t.N = first ? NWI : D;
    const int item = first ? it : it - I_1, nblk = t.N / 32, kb = item / nblk, nb = item - kb * nblk;
    t.k0 = 64 * kb; t.n0 = 32 * nb;
    const int bj = t.n0 / DFF, j = t.n0 - bj * DFF;
    t.r0 = first ? ((j >> 7) * 256 + bj * 128 + (j & 127)) : t.n0;
    return t;
}
__device__ __forceinline__ TrItem tr_decode0(const Params& p, unsigned char* ws, int it) {
    constexpr int I_1 = (D / 64) * (NWI / 32), I_2 = (DFF / 64) * (D / 32), I_3 = (D / 64) * (INW / 32);
    const int sel = it < I_1 ? 0 : (it < I_1 + I_2 ? 1 : (it < I_1 + I_2 + I_3 ? 2 : 3));
    TrItem t;
    t.W = sel == 0 ? p.in[I_WIA] : (sel == 1 ? p.in[I_WOA] : (sel == 2 ? p.in[I_WIN] : p.in[I_WOUT]));
    t.WT = (bf16_t*)(ws + (sel == 0 ? WS_WIA : (sel == 1 ? WS_WOA : (sel == 2 ? WS_WIN : WS_WOUT))));
    t.K = sel == 1 ? DFF : D; t.N = sel == 0 ? NWI : (sel == 2 ? INW : D);
    const int item = it - (sel == 0 ? 0 : (sel == 1 ? I_1 : (sel == 2 ? I_1 + I_2 : I_1 + I_2 + I_3)));
    const int nblk = t.N / 32, kb = item / nblk, nb = item - kb * nblk;
    t.k0 = 64 * kb; t.n0 = 32 * nb;
    const int bj = t.n0 / DFF, j = t.n0 - bj * DFF;
    t.r0 = sel == 0 ? ((j >> 7) * 256 + bj * 128 + (j & 127)) : t.n0;
    return t;
}
__device__ __forceinline__ void tr_load(const TrItem& t, int lane, float (&wv)[32]) {
#pragma unroll
    for (int i = 0; i < 32; ++i) wv[i] = __builtin_nontemporal_load(t.W + (size_t)(t.k0 + 2 * i + (lane >> 5)) * t.N + t.n0 + (lane & 31));
}
__device__ __forceinline__ void tr_finish(const TrItem& t, LAS float* scr, int lane, const float (&wv)[32]) {
#pragma unroll
    for (int i = 0; i < 32; ++i) scr[(2 * i + (lane >> 5)) * 33 + (lane & 31)] = wv[i];
    asm volatile("s_waitcnt lgkmcnt(0)" ::: "memory");
    const int c = lane & 7;
#pragma unroll
    for (int j = 0; j < 4; ++j) { const int n = (lane >> 3) + 8 * j; const LAS float* s = scr + (8 * c) * 33 + n;
        u32x4 o; o.x = cvt_pk_bf16(s[0 * 33], s[1 * 33]); o.y = cvt_pk_bf16(s[2 * 33], s[3 * 33]); o.z = cvt_pk_bf16(s[4 * 33], s[5 * 33]); o.w = cvt_pk_bf16(s[6 * 33], s[7 * 33]);
        *(u32x4*)(t.WT + (size_t)(t.r0 + n) * t.K + t.k0 + 8 * c) = o; }
    asm volatile("s_waitcnt lgkmcnt(0)" ::: "memory");
}
template <int PH>
__device__ __forceinline__ void ln_pass(const Params& p, LAS unsigned char* lds, unsigned char* ws, float* Yx, float* Yc, const float* modv, const float* lng, const float* lnb, f32x2* st1, f32x2* st2, bf16_t* R0, int gw, int NGW, int lane, int wave) {
    constexpr int ph = PH;
            const int j = ph == 4 ? 1 : 2; const int rows = ph == 4 ? MT : MX;
            f32x2* st = ph == 4 ? st1 : st2;
            const float* lg = lng + (j - 1) * D; const float* lb = lnb + (j - 1) * D;
            LAS float* Lg = (LAS float*)lds; LAS float* Lb = Lg + D; LAS float* Ls = Lb + D; LAS float* Lt = Ls + D;
            { const int tid_ = (int)threadIdx.x; *(LAS f32x4*)(Lg + tid_ * 4) = *(const f32x4*)(lg + tid_ * 4); *(LAS f32x4*)(Lb + tid_ * 4) = *(const f32x4*)(lb + tid_ * 4); }
            int cur_mr = -1;
            f32x4 nv[8];
            if (gw < rows) { const float* y0 = gw < MX ? Yx + (size_t)gw * D : p.in[I_CTX] + (size_t)(gw - MX) * D;
#pragma unroll
                for (int q = 0; q < 8; ++q) nv[q] = *(const f32x4*)(y0 + q * 256 + lane * 4); }
            for (int m = gw; m < rows; m += NGW) {
                const bool isx = m < MX; const int mr = isx ? (m >> 12) : 8;
                if (mr != cur_mr) {
                    const float* sh = modv + (size_t)mr * MODW + 3 * j * D; const int tid_ = (int)threadIdx.x;
                    __syncthreads();
                    *(LAS f32x4*)(Lt + tid_ * 4) = *(const f32x4*)(sh + tid_ * 4); *(LAS f32x4*)(Ls + tid_ * 4) = *(const f32x4*)(sh + D + tid_ * 4);
                    __syncthreads();
                    cur_mr = mr;
                }
                f32x4 v[8]; float s = 0.f;
#pragma unroll
                for (int q = 0; q < 8; ++q) v[q] = nv[q];
                { const int mn = m + NGW < rows ? m + NGW : m; const float* yn = mn < MX ? Yx + (size_t)mn * D : p.in[I_CTX] + (size_t)(mn - MX) * D;
#pragma unroll
                  for (int q = 0; q < 8; ++q) nv[q] = *(const f32x4*)(yn + q * 256 + lane * 4); }
                if (!isx) {
#pragma unroll
                    for (int q = 0; q < 8; ++q) {
                        const float* pp = (const float*)(ws + WS_PART) + (size_t)(m - MX) * D + q * 256 + lane * 4;
                        const f32x4 ps = (*(const f32x4*)pp + *(const f32x4*)(pp + (size_t)MC * D)) + (*(const f32x4*)(pp + (size_t)2 * MC * D) + *(const f32x4*)(pp + (size_t)3 * MC * D));
                        v[q] = ALPHA * v[q] + 0.5f * *(const f32x4*)(modv + (size_t)8 * MODW + 2 * D + q * 256 + lane * 4) * ps; }
                }
#pragma unroll
                for (int q = 0; q < 8; ++q) s += (v[q][0] + v[q][1]) + (v[q][2] + v[q][3]);
                const float mean = wave_sum(s) * (1.0f / D); float s2 = 0.f;
#pragma unroll
                for (int q = 0; q < 8; ++q) { v[q] = v[q] - mean; s2 += (v[q][0] * v[q][0] + v[q][1] * v[q][1]) + (v[q][2] * v[q][2] + v[q][3] * v[q][3]); }
                const float rstd = 1.0f / sqrtf(wave_sum(s2) * (1.0f / D) + LN_EPS);
                if (lane == 0) st[m] = (f32x2){mean, rstd};
                bf16_t* o = R0 + (size_t)m * D;
#pragma unroll
                for (int hq = 0; hq < 2; ++hq) {
                    f32x4 g4[4], b4[4], s4[4], t4[4];
#pragma unroll
                    for (int u = 0; u < 4; ++u) { const int c = (hq * 4 + u) * 256 + lane * 4; g4[u] = *(const LAS f32x4*)(Lg + c); b4[u] = *(const LAS f32x4*)(Lb + c); s4[u] = *(const LAS f32x4*)(Ls + c); t4[u] = *(const LAS f32x4*)(Lt + c); }
#pragma unroll
                    for (int u = 0; u < 4; ++u) { const int q = hq * 4 + u, c = q * 256 + lane * 4;
                        const f32x4 xn = v[q] * rstd * g4[u] + b4[u];
                        const f32x4 h = xn * (1.0f + s4[u]) + t4[u];
                        u32x2 w; w.x = cvt_pk_bf16(h[0], h[1]); w.y = cvt_pk_bf16(h[2], h[3]); *(u32x2*)(o + c) = w; }
                }
            }
            if (ph == 12) {
                __syncthreads();
                LAS float* scr = (LAS float*)(lds + wave * 16384);
                constexpr int NIT = (D / 64) * (NWI / 32) + (DFF / 64) * (D / 32);
                if (gw < NIT) {
                    TrItem t = tr_decode(p, ws, gw); float wv[32]; tr_load(t, lane, wv);
                    for (int it = gw; it < NIT; it += NGW) {
                        const TrItem tn = tr_decode(p, ws, it + NGW < NIT ? it + NGW : it); float wn[32]; tr_load(tn, lane, wn);
                        tr_finish(t, scr, lane, wv);
                        t = tn;
#pragma unroll
                        for (int i = 0; i < 32; ++i) wv[i] = wn[i];
                    }
                }
            }
}

__global__ void __launch_bounds__(512, 2) fwd_megakernel(Params p) {
    extern __shared__ __attribute__((aligned(16))) unsigned char lds_raw[];
    LAS unsigned char* lds = (LAS unsigned char*)lds_raw;
    const int tid = threadIdx.x, lane = tid & 63, wave = __builtin_amdgcn_readfirstlane(tid >> 6);
    const int G = gridDim.x, bid = blockIdx.x;
    const int gw = bid * 8 + wave, NGW = G * 8;
    unsigned char* ws = p.ws;
    float* modv = (float*)(ws + WS_MODV);
    f32x2* st1 = (f32x2*)(ws + WS_ST1); f32x2* st2 = (f32x2*)(ws + WS_ST2);
    bf16_t* R0 = (bf16_t*)(ws + WS_R0);
    float* Yx = p.out; float* Yc = (float*)(ws + WS_Y1C);
    const float* lng = p.in[I_LNG]; const float* lnb = p.in[I_LNB];

    cg::grid_group grid = cg::this_grid();
    const int lo = p.ph_lo, hi = p.ph_hi;
    volatile LAS unsigned* bst = (volatile LAS unsigned*)(lds + LDS_BYTES - 16);
    if (tid < 4) bst[tid] = 0u;
    __syncthreads();
    XcdBarrier xbar = xcd_barrier_post((unsigned*)ws, bst);
    if (hi > 1000) grid.sync();
#define IN(k) (lo <= (k) && (k) < hi)
#define SEAM(k) do { if (IN(k) && IN((k) + 1)) xcd_barrier(xbar); } while (0)
        if (PH_ON(0) && IN(0)) for (int rep_ = 0; rep_ < NREP(0); ++rep_) { if (rep_) xcd_barrier(xbar);
            LAS float* scr = (LAS float*)(lds + wave * 16384);
            constexpr int NIT0 = (D / 64) * (NWI / 32) + (DFF / 64) * (D / 32) + (D / 64) * (INW / 32) + (D / 64) * (D / 32);
            if (gw < NIT0) {
                TrItem t = tr_decode0(p, ws, gw); float wv[32]; tr_load(t, lane, wv);
                for (int it = gw; it < NIT0; it += NGW) {
                    const TrItem tn = tr_decode0(p, ws, it + NGW < NIT0 ? it + NGW : it); float wn[32]; tr_load(tn, lane, wn);
                    tr_finish(t, scr, lane, wv);
                    t = tn;
#pragma unroll
                    for (int i = 0; i < 32; ++i) wv[i] = wn[i];
                }
            }
            {
                bf16_t* LB = (bf16_t*)(ws + WS_LORAB);
                const float* wup = p.in[I_WUP]; const float* aup = p.in[I_AUP]; const float* gup = p.in[I_GUP];
                for (int i = bid * 512 + tid; i < NLORA * KLORA; i += G * 512) {
                    const int n = i >> 8, k = i & 255, reg = n >> 10, cc = n & 1023; float v = 0.f;
                    if (reg < 2) { if (k < 64) v = wup[((size_t)reg * 64 + k) * RW + cc]; }
                    else if (reg < 4) { if (k >= 64 && k < 128) v = aup[((size_t)(reg - 2) * 64 + (k - 64)) * RW + cc]; }
                    else { if (k >= 128) v = gup[(size_t)(k - 128) * RW + cc]; }
                    LB[i] = (bf16_t)(cvt_pk_bf16(v, 0.f) & 0xffffu);
                }
                float* LBI = (float*)(ws + WS_LBIAS);
                for (int i = bid * 512 + tid; i < NLORA; i += G * 512) LBI[i] = i < 2048 ? p.in[I_W0][i] : (i < 4096 ? p.in[I_A0][i - 2048] : 0.f);
                bf16_t* WSB = (bf16_t*)(ws + WS_WSB); const float* gws = p.in[I_GMWS];
                for (int i = bid * 512 + tid; i < 16 * 128 * 128; i += G * 512) WSB[i] = (bf16_t)(cvt_pk_bf16(gws[i], 0.f) & 0xffffu);
            }
            __syncthreads();
            {
                LAS float* sb = (LAS float*)lds;
                LAS float* red = (LAS float*)(lds + 9 * 2048 * 4);
                for (int i = tid; i < 9 * D; i += 512) { const int r = i >> 11, k = i & 2047; const float v = r < 8 ? p.in[I_C][r * D + k] : p.in[I_CCTX][k]; sb[i] = siluf(v); }
                __syncthreads();
                const float* wada = p.in[I_WADA]; const float* bada = p.in[I_BADA];
                for (int tk = bid; tk < MODW / 32; tk += G) {
                    const int c0 = tk * 32, col = lane & 31, kh = lane >> 5;
                    float a[9];
#pragma unroll
                    for (int r = 0; r < 9; ++r) a[r] = 0.f;
                    const float* wp = wada + (size_t)(wave * 256 + kh) * MODW + c0 + col;
                    const LAS float* sp = sb + wave * 256 + kh;
                    for (int k16 = 0; k16 < 256; k16 += 32) {
                        float wv[16];
#pragma unroll
                        for (int j = 0; j < 16; ++j) wv[j] = __builtin_nontemporal_load(wp + (size_t)(k16 + 2 * j) * MODW);
#pragma unroll
                        for (int j = 0; j < 16; ++j)
#pragma unroll
                            for (int r = 0; r < 9; ++r) a[r] += sp[r * D + k16 + 2 * j] * wv[j];
                    }
#pragma unroll
                    for (int r = 0; r < 9; ++r) { a[r] += __shfl_xor(a[r], 32); if (lane < 32) red[(wave * 9 + r) * 32 + col] = a[r]; }
                    __syncthreads();
                    for (int i = tid; i < 9 * 32; i += 512) { const int r = i >> 5, l = i & 31; float sacc = 0.f;
#pragma unroll
                        for (int w = 0; w < 8; ++w) sacc += red[(w * 9 + r) * 32 + l];
                        modv[(size_t)r * MODW + c0 + l] = sacc + bada[c0 + l]; }
                    __syncthreads();
                }
            }
        } SEAM(0);

        if (PH_ON(1) && IN(1)) for (int rep_ = 0; rep_ < NREP(1); ++rep_) { if (rep_) xcd_barrier(xbar);
            LAS float* Ls = (LAS float*)lds; LAS float* Lt = Ls + D; int cur_mr = -1;
            f32x4 nx[8];
            { const float* x0 = gw < MX ? p.in[I_X] + (size_t)gw * D : p.in[I_CTX] + (size_t)(gw - MX) * D;
#pragma unroll
              for (int j = 0; j < 8; ++j) nx[j] = *(const f32x4*)(x0 + j * 256 + lane * 4); }
            for (int m = gw; m < MT; m += NGW) {
                const bool isx = m < MX; const int mr = isx ? (m >> 12) : 8;
                if (mr != cur_mr) {
                    const float* sh = modv + (size_t)mr * MODW;
                    __syncthreads();
                    *(LAS f32x4*)(Lt + tid * 4) = *(const f32x4*)(sh + tid * 4); *(LAS f32x4*)(Ls + tid * 4) = *(const f32x4*)(sh + D + tid * 4);
                    __syncthreads();
                    cur_mr = mr;
                }
                bf16_t* o = R0 + (size_t)m * D;
                f32x4 xv[8], sv[8], tv[8];
#pragma unroll
                for (int j = 0; j < 8; ++j) { const int c = j * 256 + lane * 4; xv[j] = nx[j]; sv[j] = *(const LAS f32x4*)(Ls + c); tv[j] = *(const LAS f32x4*)(Lt + c); }
                { const int mn = m + NGW < MT ? m + NGW : m; const float* xn = mn < MX ? p.in[I_X] + (size_t)mn * D : p.in[I_CTX] + (size_t)(mn - MX) * D;
#pragma unroll
                  for (int j = 0; j < 8; ++j) nx[j] = *(const f32x4*)(xn + j * 256 + lane * 4); }
#pragma unroll
                for (int j = 0; j < 8; ++j) { const int c = j * 256 + lane * 4;
                    const f32x4 h = xv[j] * (1.0f + sv[j]) + tv[j]; u32x2 w; w.x = cvt_pk_bf16(h[0], h[1]); w.y = cvt_pk_bf16(h[2], h[3]); *(u32x2*)(o + c) = w; }
            }
        } SEAM(1);
        if (PH_ON(2) && IN(2)) for (int rep_ = 0; rep_ < NREP(2); ++rep_) { if (rep_) xcd_barrier(xbar);
            pg8::Gemm g{R0, (const bf16_t*)(ws + WS_WIA), MT, NWI, D, D}; pg8::StaticOrder S; S.init(MT, NWI, G, bid);
            EpiSwiglu E{(bf16_t*)(ws + WS_R1)};
            pg8::gemm_phase<EpiSwiglu, pg8::StaticOrder>(lds, g, S, E);
        } SEAM(2);
        if (PH_ON(3) && IN(3)) for (int rep_ = 0; rep_ < NREP(3); ++rep_) { if (rep_) xcd_barrier(xbar);
            pg8::Gemm g{(const bf16_t*)(ws + WS_R1), (const bf16_t*)(ws + WS_WOA), MX, D, DFF, DFF}; pg8::StaticOrder S; S.init(MX, D, G, bid);
            EpiResid E{p.in[I_X], p.in[I_CTX], Yx, Yc, nullptr, nullptr, nullptr, modv, 2, 0.5f};
            pg8::gemm_phase<EpiResid, pg8::StaticOrder>(lds, g, S, E);
            pg8::Gemm g2{(const bf16_t*)(ws + WS_R1), (const bf16_t*)(ws + WS_WOA), MC, D, DFF / 4, DFF}; pg8::SplitOrder S2{MC / 256, D / 256, 4, MX / 256, G, bid};
            EpiPartial E2{(float*)(ws + WS_PART)};
            pg8::gemm_phase<EpiPartial, pg8::SplitOrder>(lds, g2, S2, E2);
        } SEAM(3);
        if (PH_ON(4) && IN(4)) for (int rep_ = 0; rep_ < NREP(4); ++rep_) { if (rep_) xcd_barrier(xbar); ln_pass<4>(p, lds, ws, Yx, Yc, modv, lng, lnb, st1, st2, R0, gw, NGW, lane, wave); } SEAM(4);
        if (PH_ON(5) && IN(5)) for (int rep_ = 0; rep_ < NREP(5); ++rep_) { if (rep_) xcd_barrier(xbar);
            pg8::Gemm g{R0, (const bf16_t*)(ws + WS_WIN), MT, INW, D, D}; pg8::RectOrder S; S.init(MX, INW, MC / 256, RIN / 256, G, bid);
            EpiF16 E{(f16_t*)(ws + WS_R1), INW};
            pg8::gemm_phase<EpiF16, pg8::RectOrder>(lds, g, S, E);
        } SEAM(5);
        if (PH_ON(6) && IN(6)) for (int rep_ = 0; rep_ < NREP(6); ++rep_) { if (rep_) xcd_barrier(xbar);
            const f16_t* P = (const f16_t*)(ws + WS_R1);
            f16_t* RKV = (f16_t*)(ws + WS_R2); bf16_t* AL = (bf16_t*)(ws + WS_ALORA);
            const float* mu = p.in[I_MU];
            for (int m = gw; m < MT; m += NGW) {
                const bool isx = m < MX;
                const f16_t* pr = P + (size_t)m * INW;
                bool okA, okB, okC = false, okD = false; long dA, dB, dC = 0, dD = 0;
                if (isx) { const int t = m & 4095, gr = t >> 6, gc = t & 63; okA = gc > 0; okB = gc < 63; okC = gr > 0; okD = gr < 63; dA = -1; dB = 1; dC = -64; dD = 64; }
                else { const int t = (m - MX) & 255; okA = t > 0; okB = t < 255; dA = -1; dB = 1; }
                const f16_t* pA = okA ? pr + dA * INW : pr; const f16_t* pB = okB ? pr + dB * INW : pr;
                const f16_t* pC = okC ? pr + dC * INW : pr; const f16_t* pD = okD ? pr + dD * INW : pr;
                const u32x4 z = (u32x4){0u, 0u, 0u, 0u};
                for (int base = 0; base < 7; base += 4) {
                    u32x4 own[4], vA[4], vB[4], vC[4], vD[4]; f32x4 mu0a[4], mu1a[4];
#pragma unroll
                    for (int u = 0; u < 4; ++u) { int ci = lane + 64 * (base + u); ci = ci < RIN / 8 ? ci : RIN / 8 - 1; const int c = ci * 8;
                        own[u] = *(const u32x4*)(pr + c); vA[u] = *(const u32x4*)(pA + c); vB[u] = *(const u32x4*)(pB + c); vC[u] = *(const u32x4*)(pC + c); vD[u] = *(const u32x4*)(pD + c);
                        mu0a[u] = *(const f32x4*)(mu + c); mu1a[u] = *(const f32x4*)(mu + c + 4); }
#pragma unroll
                    for (int u = 0; u < 4; ++u) {
                        const int ci = lane + 64 * (base + u); const int c = ci * 8;
                        if (ci < RIN / 8) {
                            float fo[8], fA[8], fB[8], fC[8], fD[8], xs[8];
                            h8_to_f(own[u], fo); h8_to_f(okA ? vA[u] : z, fA); h8_to_f(okB ? vB[u] : z, fB); h8_to_f(okC ? vC[u] : z, fC); h8_to_f(okD ? vD[u] : z, fD);
                            const f32x4 mu0 = mu0a[u], mu1 = mu1a[u];
#pragma unroll
                            for (int j = 0; j < 8; ++j) {
                                float sh;
                                if (isx) sh = (j & 3) == 0 ? fA[j] : (j & 3) == 1 ? fB[j] : (j & 3) == 2 ? fC[j] : fD[j];
                                else sh = (j & 1) == 0 ? fA[j] : fB[j];
                                const float mj = j < 4 ? mu0[j] : mu1[j - 4];
                                xs[j] = fo[j] + (sh - fo[j]) * mj;
                            }
                            if (c < 3 * RW) {
                                u32x4 w; w.x = pk_f16(xs[0], xs[1]); w.y = pk_f16(xs[2], xs[3]); w.z = pk_f16(xs[4], xs[5]); w.w = pk_f16(xs[6], xs[7]);
                                *(u32x4*)(RKV + (size_t)m * 3072 + c) = w;
                            } else {
                                const int cl = c - 3 * RW;
#pragma unroll
                                for (int j = 0; j < 8; ++j) { if (cl < 64) xs[j] = tanh_f(xs[j]); else if (cl >= 128) xs[j] = sigm(xs[j]); }
                                u32x4 w; w.x = cvt_pk_bf16(xs[0], xs[1]); w.y = cvt_pk_bf16(xs[2], xs[3]); w.z = cvt_pk_bf16(xs[4], xs[5]); w.w = cvt_pk_bf16(xs[6], xs[7]);
                                *(u32x4*)(AL + (size_t)m * 256 + cl) = w;
                            }
                        }
                    }
                }
            }
            {
                bf16_t* VT = (bf16_t*)(ws + WS_VT);
                const float* gg = p.in[I_GMG]; const float* gb = p.in[I_GMB];
                for (int tk = gw; tk < NB * 32 * 2 * 16; tk += NGW) {
                    const int g = tk & 15, hh = (tk >> 4) & 1, bn = tk >> 5;
                    const int q = hh * 64 + lane; const size_t m = (size_t)bn * 128 + q;
                    const f16_t* src = P + m * INW + RIN + RW + g * 64;
                    float v[64]; float s = 0.f;
#pragma unroll
                    for (int i = 0; i < 8; ++i) { float f[8]; h8_to_f(*(const u32x4*)(src + i * 8), f);
#pragma unroll
                        for (int j = 0; j < 8; ++j) { v[i * 8 + j] = gelu_t(f[j]); s += v[i * 8 + j]; } }
                    const float mean = s * (1.0f / 64.0f); float s2 = 0.f;
#pragma unroll
                    for (int d = 0; d < 64; ++d) { v[d] -= mean; s2 += v[d] * v[d]; }
                    const float rstd = 1.0f / sqrtf(s2 * (1.0f / 64.0f) + LN_EPS);
                    bf16_t* dst = VT + ((size_t)bn * 16 + g) * 64 * 128 + q;
#pragma unroll
                    for (int d = 0; d < 64; ++d) { const float o = v[d] * rstd * gg[g * 64 + d] + gb[g * 64 + d]; dst[d * 128] = (bf16_t)(cvt_pk_bf16(o, 0.f) & 0xffffu); }
                }
            }
        } SEAM(6);
        if (PH_ON(7) && IN(7)) for (int rep_ = 0; rep_ < NREP(7); ++rep_) { if (rep_) xcd_barrier(xbar);
            const f16_t* P = (const f16_t*)(ws + WS_R1);
            const bf16_t* VT = (const bf16_t*)(ws + WS_VT); const bf16_t* WSB = (const bf16_t*)(ws + WS_WSB);
            const float* bs = p.in[I_GMBS];
            const int fr = lane & 15, fq = lane >> 4;
            for (int tk = gw; tk < NB * 32 * 16; tk += NGW) {
                const int g = tk & 15, bn = tk >> 4;
                const bf16_t* vb = VT + ((size_t)bn * 16 + g) * 64 * 128;
                const bf16_t* wb = WSB + (size_t)g * 128 * 128;
                bf16x8 vf[4][4];
#pragma unroll
                for (int nt = 0; nt < 4; ++nt)
#pragma unroll
                    for (int kk = 0; kk < 4; ++kk) vf[nt][kk] = *(const bf16x8*)(vb + (nt * 16 + fr) * 128 + kk * 32 + fq * 8);
                bf16x8 wfn[4]; u32x2 un[4]; float bsn;
#define P7_LOAD(mt_) do { const int pt_ = (mt_) * 16 + fr; const size_t m_ = (size_t)bn * 128 + pt_; \
                    _Pragma("unroll") for (int kk = 0; kk < 4; ++kk) wfn[kk] = *(const bf16x8*)(wb + pt_ * 128 + kk * 32 + fq * 8); \
                    _Pragma("unroll") for (int nt = 0; nt < 4; ++nt) un[nt] = *(const u32x2*)(P + m_ * INW + RIN + g * 64 + nt * 16 + fq * 4); \
                    bsn = bs[g * 128 + pt_]; } while (0)
                P7_LOAD(0);
#pragma unroll 2
                for (int mt = 0; mt < 8; ++mt) {
                    bf16x8 wf[4]; u32x2 uc[4]; const float bsv = bsn;
#pragma unroll
                    for (int kk = 0; kk < 4; ++kk) { wf[kk] = wfn[kk]; uc[kk] = un[kk]; }
                    { const int mtn = mt < 7 ? mt + 1 : 7; P7_LOAD(mtn); }
                    f32x4 acc[4];
#pragma unroll
                    for (int nt = 0; nt < 4; ++nt) { acc[nt] = (f32x4){0.f, 0.f, 0.f, 0.f};
#pragma unroll
                        for (int kk = 0; kk < 4; ++kk) acc[nt] = __builtin_amdgcn_mfma_f32_16x16x32_bf16(vf[nt][kk], wf[kk], acc[nt], 0, 0, 0); }
                    const int pt = mt * 16 + fr; const size_t m = (size_t)bn * 128 + pt;
#pragma unroll
                    for (int nt = 0; nt < 4; ++nt) {
                        const int d0 = nt * 16 + fq * 4;
                        const h16x4 uh = __builtin_bit_cast(h16x4, uc[nt]);
                        float o[4];
#pragma unroll
                        for (int j = 0; j < 4; ++j) o[j] = gelu_t((float)uh[j]) * (acc[nt][j] + bsv);
                        u32x2 w; w.x = cvt_pk_bf16(o[0], o[1]); w.y = cvt_pk_bf16(o[2], o[3]);
                        *(u32x2*)(R0 + m * D + RW + g * 64 + d0) = w;
                    }
                }
#undef P7_LOAD
            }
        } SEAM(7);
        if (PH_ON(8) && IN(8)) for (int rep_ = 0; rep_ < NREP(8); ++rep_) { if (rep_) xcd_barrier(xbar);
            pg8::Gemm g{(const bf16_t*)(ws + WS_ALORA), (const bf16_t*)(ws + WS_LORAB), MT, NLORA, KLORA / 2, KLORA}; pg8::LoraOrder S; S.so.init(MT, NLORA, G, bid);
            EpiLora E{(f16_t*)(ws + WS_R1), (const float*)(ws + WS_LBIAS)};
            pg8::gemm_phase<EpiLora, pg8::LoraOrder>(lds, g, S, E);
        } SEAM(8);
        if (PH_ON(9) && IN(9)) for (int rep_ = 0; rep_ < NREP(9); ++rep_) { if (rep_) xcd_barrier(xbar);
            const f16_t* RKV = (const f16_t*)(ws + WS_R2); const f16_t* L = (const f16_t*)(ws + WS_R1);
            f16_t* YSC = (f16_t*)(ws + WS_YSC);
            constexpr int TC = 32, NCH = (CTXL + SEQ) / TC, NSUB = 2 * NCH, LD64 = 72, LD32 = 40;
            constexpr int RS = 68, AS = 32 * RS;
            LAS float* raw = (LAS float*)lds;
            LAS float* ybuf = (LAS float*)(lds + 52224);
            LAS float* AabT = (LAS float*)(lds + 120320);
            LAS float* ScT = (LAS float*)(lds + 121344);
            LAS float* ScT2 = (LAS float*)(lds + 121600);
            LAS float* ScM = (LAS float*)(lds + 121856);
            LAS bf16_t* XTa = (LAS bf16_t*)(lds + 122112);
            LAS bf16_t* UTa = (LAS bf16_t*)(lds + 127232);
            LAS bf16_t* SB = (LAS bf16_t*)(lds + 132352);
#define D64(pb_, q_) ((LAS bf16_t*)(lds + 60416 + (pb_) * 9216 + (q_) * 2304))
#define D32(pb_, q_) ((LAS bf16_t*)(lds + 78848 + (pb_) * 15360 + (q_) * 5120))
#define P16B(pb_) ((LAS float*)(lds + 109568 + (pb_) * 256))
#define AMB(pb_, q_) ((LAS bf16_t*)(lds + 110080 + (pb_) * 5120 + (q_) * 1280))
            const int fr = lane & 15, fq = lane >> 4;
#define FRAG(M_, ld_, rb_, kk_) (*(const LAS bf16x8*)((M_) + ((rb_) + fr) * (ld_) + (kk_) * 32 + fq * 8))
#define LDSFENCE() asm volatile("s_waitcnt lgkmcnt(0)" ::: "memory")
            for (int sid = bid; sid < NB * NH * 2; sid += G) {
                const int dir = sid & 1, h = (sid >> 1) & 15, b = sid >> 5;
                const int ps = tid >> 4, kg = tid & 15, ch = h * 64 + 4 * kg;
                const f32x4 kkp = *(const f32x4*)(p.in[I_KK] + ch), kap = *(const f32x4*)(p.in[I_KA] + ch);
                const f16_t* Le = L + (size_t)dir * MT * RW; const f16_t* Li = L + (size_t)(2 + dir) * MT * RW;
                for (int i = tid; i < (141568 - 60416) / 4; i += 512) ((LAS unsigned*)(lds + 60416))[i] = 0u;
                f32x4 accS[4], accY = (f32x4){0.f, 0.f, 0.f, 0.f};
#pragma unroll
                for (int q = 0; q < 4; ++q) accS[q] = (f32x4){0.f, 0.f, 0.f, 0.f};
                u32x2 pr_, pk_, pv_, pi_, pe_;
#define TOKROW(c_) (((c_) * TC + ps) < CTXL ? (MX + b * CTXL + (dir ? (CTXL - 1 - ((c_) * TC + ps)) : ((c_) * TC + ps))) : (b * SEQ + (dir ? (SEQ - 1 - ((c_) * TC + ps - CTXL)) : ((c_) * TC + ps - CTXL))))
#define PREFETCH(c_) do { const int mr_ = TOKROW(c_); const f16_t* q_ = RKV + (size_t)mr_ * 3072 + ch; \
                    pr_ = *(const u32x2*)q_; pk_ = *(const u32x2*)(q_ + RW); pv_ = *(const u32x2*)(q_ + 2 * RW); \
                    pi_ = *(const u32x2*)(Li + (size_t)mr_ * RW + ch); pe_ = *(const u32x2*)(Le + (size_t)mr_ * RW + ch); } while (0)
#define PREPROC() do {   \
                    const h16x4 hr = __builtin_bit_cast(h16x4, pr_), hk = __builtin_bit_cast(h16x4, pk_), hv = __builtin_bit_cast(h16x4, pv_), hi = __builtin_bit_cast(h16x4, pi_), he = __builtin_bit_cast(h16x4, pe_); \
                    f32x4 k4, kk4, ic4, e4, r4, v4; \
                    _Pragma("unroll") for (int j_ = 0; j_ < 4; ++j_) { k4[j_] = (float)hk[j_]; ic4[j_] = (float)hi[j_]; r4[j_] = (float)hr[j_]; v4[j_] = (float)hv[j_]; e4[j_] = (float)he[j_]; } \
                    kk4 = k4 * kkp; \
                    float ss = (kk4[0] * kk4[0] + kk4[1] * kk4[1]) + (kk4[2] * kk4[2] + kk4[3] * kk4[3]); \
                    ss += dpp_f<DPP_XOR1>(ss); ss += dpp_f<DPP_XOR2>(ss); ss += dpp_f<DPP_HALF_MIRROR>(ss); ss += dpp_f<DPP_MIRROR>(ss); \
                    const float inv = __builtin_amdgcn_rsqf(fmaxf(ss, 1e-24f));        \
                    kk4 = kk4 * inv; \
                    const f32x4 kd4 = k4 * (1.0f + (ic4 - 1.0f) * kap), bb4 = kk4 * ic4; \
                    const int o_ = ps * RS + 4 * kg; \
                    *(LAS f32x4*)(raw + 0 * AS + o_) = e4; *(LAS f32x4*)(raw + 1 * AS + o_) = kk4; *(LAS f32x4*)(raw + 2 * AS + o_) = bb4; \
                    *(LAS f32x4*)(raw + 3 * AS + o_) = kd4; *(LAS f32x4*)(raw + 4 * AS + o_) = r4; *(LAS f32x4*)(raw + 5 * AS + o_) = v4; } while (0)
#define FLUSH(c_) do { const f32x4 y4 = *(const LAS f32x4*)(ybuf + ps * 64 + 4 * kg); u32x2 w_; w_.x = pk_f16(y4[0], y4[1]); w_.y = pk_f16(y4[2], y4[3]); \
                    *(u32x2*)(YSC + (size_t)dir * MX * RW + (size_t)TOKROW(c_) * RW + ch) = w_; } while (0)
                PREFETCH(0);
                PREPROC();
                PREFETCH(1);
                __syncthreads();
                for (int j = -1; j < NSUB; ++j) {
                    const int pb = j & 1, s0 = (j & 1) * 16;
                    if (wave < 4) {
                        if (j >= 0) {
                            f32x4 accX = (f32x4){0.f, 0.f, 0.f, 0.f}; accY = accX;
#pragma unroll
                            for (int kk = 0; kk < 2; ++kk) { const bf16x8 bS = FRAG(SB, LD64, wave * 16, kk);
                                accX = __builtin_amdgcn_mfma_f32_16x16x32_bf16(FRAG(D64(pb, 0), LD64, 0, kk), bS, accX, 0, 0, 0);
                                accY = __builtin_amdgcn_mfma_f32_16x16x32_bf16(bS, FRAG(D64(pb, 1), LD64, 0, kk), accY, 0, 0, 0); }
                            const bf16x8 vB = FRAG(D32(pb, 2), LD32, wave * 16, 0);
                            accX = __builtin_amdgcn_mfma_f32_16x16x32_bf16(FRAG(AMB(pb, 0), LD32, 0, 0), vB, accX, 0, 0, 0);
                            accY = __builtin_amdgcn_mfma_f32_16x16x32_bf16(vB, FRAG(AMB(pb, 1), LD32, 0, 0), accY, 0, 0, 0);
                            { u32x2 w_; w_.x = cvt_pk_bf16(accX[0], accX[1]); w_.y = cvt_pk_bf16(accX[2], accX[3]); *(LAS u32x2*)(XTa + (wave * 16 + fr) * LD32 + fq * 4) = w_; }
                            LDSFENCE();
                            const bf16x8 xB = FRAG(XTa, LD32, wave * 16, 0);
                            const f32x4 accU = __builtin_amdgcn_mfma_f32_16x16x32_bf16(FRAG(AMB(pb, 3), LD32, 0, 0), xB, (f32x4){0.f, 0.f, 0.f, 0.f}, 0, 0, 0);
                            { u32x2 w_; w_.x = cvt_pk_bf16(accU[0], accU[1]); w_.y = cvt_pk_bf16(accU[2], accU[3]); *(LAS u32x2*)(UTa + (wave * 16 + fr) * LD32 + fq * 4) = w_; }
                        }
                    } else if (j + 1 < NSUB) {
                        const int pbn = (j + 1) & 1, s0n = ((j + 1) & 1) * 16, tp = tid - 256, t = tp & 15, k0 = 4 * (tp >> 4);
                        const int ro = (s0n + t) * RS + k0;
                        const f32x4 e4 = *(const LAS f32x4*)(raw + ro), kk4 = *(const LAS f32x4*)(raw + AS + ro), bb4 = *(const LAS f32x4*)(raw + 2 * AS + ro), kd4 = *(const LAS f32x4*)(raw + 3 * AS + ro), r4 = *(const LAS f32x4*)(raw + 4 * AS + ro), v4 = *(const LAS f32x4*)(raw + 5 * AS + ro);
                        f32x4 Pt, Pp, iP, PC;
#pragma unroll
                        for (int q = 0; q < 4; ++q) { float x = e4[q];
                            x += dpp_fz<0x111>(x); x += dpp_fz<0x112>(x); x += dpp_fz<0x114>(x); x += dpp_fz<0x118>(x);
                            const float pt = __expf(-x), sh = dpp_fz<0x111>(pt);
                            Pt[q] = pt; Pp[q] = (t == 0) ? 1.0f : sh; iP[q] = __builtin_amdgcn_rcpf(pt); PC[q] = iP[q] * __shfl(pt, lane | 15); }
                        { u32x2 w_;
                          w_.x = cvt_pk_bf16(-kk4[0] * Pp[0], -kk4[1] * Pp[1]); w_.y = cvt_pk_bf16(-kk4[2] * Pp[2], -kk4[3] * Pp[3]); *(LAS u32x2*)(D64(pbn, 0) + t * LD64 + k0) = w_;
                          w_.x = cvt_pk_bf16(r4[0] * Pt[0], r4[1] * Pt[1]); w_.y = cvt_pk_bf16(r4[2] * Pt[2], r4[3] * Pt[3]); *(LAS u32x2*)(D64(pbn, 1) + t * LD64 + k0) = w_;
                          w_.x = cvt_pk_bf16(bb4[0] * iP[0], bb4[1] * iP[1]); w_.y = cvt_pk_bf16(bb4[2] * iP[2], bb4[3] * iP[3]); *(LAS u32x2*)(D64(pbn, 2) + t * LD64 + k0) = w_;
                          w_.x = cvt_pk_bf16(kd4[0] * iP[0], kd4[1] * iP[1]); w_.y = cvt_pk_bf16(kd4[2] * iP[2], kd4[3] * iP[3]); *(LAS u32x2*)(D64(pbn, 3) + t * LD64 + k0) = w_; }
                        {
                            unsigned own[6];
                            own[0] = cvt_pk_bf16(bb4[0] * PC[0], bb4[1] * PC[1]); own[1] = cvt_pk_bf16(bb4[2] * PC[2], bb4[3] * PC[3]);
                            own[2] = cvt_pk_bf16(kd4[0] * PC[0], kd4[1] * PC[1]); own[3] = cvt_pk_bf16(kd4[2] * PC[2], kd4[3] * PC[3]);
                            own[4] = cvt_pk_bf16(v4[0], v4[1]); own[5] = cvt_pk_bf16(v4[2], v4[3]);
                            const bool ev = (t & 1) == 0;
#pragma unroll
                            for (int q = 0; q < 6; ++q) { const unsigned pt = dpp_u<DPP_XOR1>(own[q]);
                                const unsigned val = ev ? ((own[q] & 0xffffu) | (pt << 16)) : ((pt >> 16) | (own[q] & 0xffff0000u));
                                const int row = k0 + 2 * (q & 1) + (ev ? 0 : 1), col = ev ? t : t - 1;
                                *(LAS unsigned*)(D32(pbn, q >> 1) + row * LD32 + col) = val; }
                        }
                        if (t == 15) *(LAS f32x4*)(P16B(pbn) + k0) = Pt;
                    }
                    if (j >= 2 && (j & 1) == 0 && (j >> 1) - 1 >= CTXL / TC) FLUSH((j >> 1) - 1);
                    __syncthreads();
                    if (wave < 4) {
                        if (j >= 0) {
                            const bf16x8 uB = FRAG(UTa, LD32, wave * 16, 0);
                            accY = __builtin_amdgcn_mfma_f32_16x16x32_bf16(uB, FRAG(AMB(pb, 2), LD32, 0, 0), accY, 0, 0, 0);
                            *(LAS f32x4*)(ybuf + (s0 + fr) * 64 + wave * 16 + fq * 4) = accY;
                            const bf16x8 vA = FRAG(D32(pb, 2), LD32, wave * 16, 0);
#pragma unroll
                            for (int kt = 0; kt < 4; ++kt) {
                                const f32x4 p16 = *(const LAS f32x4*)(P16B(pb) + kt * 16 + fq * 4);
                                accS[kt] = accS[kt] * p16;
                                accS[kt] = __builtin_amdgcn_mfma_f32_16x16x32_bf16(FRAG(D32(pb, 1), LD32, kt * 16, 0), vA, accS[kt], 0, 0, 0);
                                accS[kt] = __builtin_amdgcn_mfma_f32_16x16x32_bf16(FRAG(D32(pb, 0), LD32, kt * 16, 0), uB, accS[kt], 0, 0, 0);
                                u32x2 w_; w_.x = cvt_pk_bf16(accS[kt][0], accS[kt][1]); w_.y = cvt_pk_bf16(accS[kt][2], accS[kt][3]);
                                *(LAS u32x2*)(SB + (wave * 16 + fr) * LD64 + kt * 16 + fq * 4) = w_;
                            }
                        }
                    } else if (j + 1 < NSUB) {
                        const int pbn = (j + 1) & 1, which = wave - 4;
                        const LAS bf16_t* Am = D64(pbn, which < 2 ? 0 : 1); const LAS bf16_t* Bm = D64(pbn, (which & 1) ? 2 : 3);
                        f32x4 a = (f32x4){0.f, 0.f, 0.f, 0.f};
#pragma unroll
                        for (int kk = 0; kk < 2; ++kk) a = __builtin_amdgcn_mfma_f32_16x16x32_bf16(FRAG(Am, LD64, 0, kk), FRAG(Bm, LD64, 0, kk), a, 0, 0, 0);
#pragma unroll
                        for (int rg = 0; rg < 4; ++rg) { const int t = fq * 4 + rg; const bool keep = which < 2 ? (t > fr) : (t >= fr); a[rg] = keep ? a[rg] : 0.f; }
                        if (which != 1) {
                            LAS bf16_t* dst = AMB(pbn, which == 0 ? 0 : (which == 2 ? 1 : 2));
#pragma unroll
                            for (int rg = 0; rg < 4; ++rg) { const float nbv = dpp_f<DPP_XOR1>(a[rg]);
                                if ((fr & 1) == 0) *(LAS unsigned*)(dst + (fq * 4 + rg) * LD32 + fr) = cvt_pk_bf16(a[rg], nbv); }
                        } else {
                            *(LAS f32x4*)(AabT + fr * 16 + fq * 4) = a;
                            LDSFENCE();
                            const int g = (lane >> 3) & 3, c = lane & 7, o = (g == 1 || g == 2) ? 8 : 0;
                            float U[8];
                            { const f32x4 h0 = *(const LAS f32x4*)(AabT + c * 16 + 8), h1 = *(const LAS f32x4*)(AabT + c * 16 + 12);
#pragma unroll
                              for (int r = 0; r < 8; ++r) { const float rh = r < 4 ? h0[r] : h1[r - 4]; U[r] = (g == 2) ? rh : ((r == c) ? 1.0f : 0.0f); } }
#pragma unroll
                            for (int i = 0; i < 7; ++i) {
                                const LAS float* colp = AabT + (o + i) * 16 + o;
                                const f32x4 c0 = *(const LAS f32x4*)colp, c1 = *(const LAS f32x4*)(colp + 4);
#pragma unroll
                                for (int r = i + 1; r < 8; ++r) U[r] += (r < 4 ? c0[r] : c1[r - 4]) * U[i];
                            }
                            if (lane < 24) { LAS float* sc = (g == 0 ? ScT : (g == 1 ? ScT2 : ScM)) + c * 8;
                                *(LAS f32x4*)sc = (f32x4){U[0], U[1], U[2], U[3]}; *(LAS f32x4*)(sc + 4) = (f32x4){U[4], U[5], U[6], U[7]}; }
                            LDSFENCE();
                            const int r21 = lane >> 3;
                            const float t11 = ScT[c * 8 + r21], t22 = ScT2[c * 8 + r21];
                            float t21 = 0.f;
                            { const f32x4 t0 = *(const LAS f32x4*)(ScT + c * 8), t1 = *(const LAS f32x4*)(ScT + c * 8 + 4);
#pragma unroll
                              for (int i = 0; i < 8; ++i) t21 += ScM[i * 8 + r21] * (i < 4 ? t0[i] : t1[i - 4]); }
                            LAS bf16_t* dst = AMB(pbn, 3);
                            const float n11 = dpp_f<DPP_XOR1>(t11), n22 = dpp_f<DPP_XOR1>(t22), n21 = dpp_f<DPP_XOR1>(t21);
                            if ((lane & 1) == 0) {
                                *(LAS unsigned*)(dst + r21 * LD32 + c) = cvt_pk_bf16(t11, n11);
                                *(LAS unsigned*)(dst + (8 + r21) * LD32 + 8 + c) = cvt_pk_bf16(t22, n22);
                                *(LAS unsigned*)(dst + (8 + r21) * LD32 + c) = cvt_pk_bf16(t21, n21);
                            }
                        }
                    }
                    if (j >= 0 && (j & 1) == 0 && (j >> 1) + 1 < NCH) { PREPROC(); if ((j >> 1) + 2 < NCH) PREFETCH((j >> 1) + 2); }
                    __syncthreads();
                }
                FLUSH(NCH - 1);
                __syncthreads();
            }
#undef FRAG
#undef LDSFENCE
#undef TOKROW
#undef PREFETCH
#undef PREPROC
#undef FLUSH
#undef D64
#undef D32
#undef P16B
#undef AMB
        } SEAM(9);

        if (PH_ON(10) && IN(10)) for (int rep_ = 0; rep_ < NREP(10); ++rep_) { if (rep_) xcd_barrier(xbar);
            const f16_t* RKV = (const f16_t*)(ws + WS_R2); const f16_t* L = (const f16_t*)(ws + WS_R1); const f16_t* YSC = (const f16_t*)(ws + WS_YSC);
            const int ch0 = lane * 16;
            float ka[16], rk[16], gng[16], gnb[16];
#pragma unroll
            for (int j = 0; j < 16; ++j) { ka[j] = p.in[I_KA][ch0 + j]; rk[j] = p.in[I_RK][ch0 + j]; gng[j] = p.in[I_GNG][ch0 + j]; gnb[j] = p.in[I_GNB][ch0 + j]; }
            for (int m = gw; m < MX; m += NGW) {
                float y[16], r[16], k[16], v[16], i0[16], i1[16], gt[16], t[8];
#define LD16(dst, ptr) do { h8_to_f(*(const u32x4*)(ptr), t); _Pragma("unroll") for (int j = 0; j < 8; ++j) dst[j] = t[j]; h8_to_f(*(const u32x4*)((ptr) + 8), t); _Pragma("unroll") for (int j = 0; j < 8; ++j) dst[8 + j] = t[j]; } while (0)
                LD16(y, YSC + (size_t)m * RW + ch0); LD16(r, YSC + (size_t)MX * RW + (size_t)m * RW + ch0);
#pragma unroll
                for (int j = 0; j < 16; ++j) y[j] += r[j];
                LD16(r, RKV + (size_t)m * 3072 + ch0); LD16(k, RKV + (size_t)m * 3072 + RW + ch0); LD16(v, RKV + (size_t)m * 3072 + 2 * RW + ch0);
                LD16(i0, L + (size_t)2 * MT * RW + (size_t)m * RW + ch0); LD16(i1, L + (size_t)3 * MT * RW + (size_t)m * RW + ch0); LD16(gt, L + (size_t)4 * MT * RW + (size_t)m * RW + ch0);
#undef LD16
                float s = 0.f, bon = 0.f;
#pragma unroll
                for (int j = 0; j < 16; ++j) { s += y[j]; const float kd = k[j] * (2.0f + (i0[j] + i1[j] - 2.0f) * ka[j]); bon += r[j] * kd * rk[j]; }
                s += dpp_f<DPP_XOR1>(s); s += dpp_f<DPP_XOR2>(s); bon += dpp_f<DPP_XOR1>(bon); bon += dpp_f<DPP_XOR2>(bon);
                const float mean = s * (1.0f / 64.0f); float s2 = 0.f;
#pragma unroll
                for (int j = 0; j < 16; ++j) { y[j] -= mean; s2 += y[j] * y[j]; }
                s2 += dpp_f<DPP_XOR1>(s2); s2 += dpp_f<DPP_XOR2>(s2);
                const float rstd = 1.0f / sqrtf(s2 * (1.0f / 64.0f) + GN_EPS);
                unsigned w[8];
#pragma unroll
                for (int j = 0; j < 16; j += 2) { const float o0 = (y[j] * rstd * gng[j] + gnb[j] + bon * v[j]) * gt[j], o1 = (y[j + 1] * rstd * gng[j + 1] + gnb[j + 1] + bon * v[j + 1]) * gt[j + 1]; w[j >> 1] = cvt_pk_bf16(o0, o1); }
                bf16_t* o = R0 + (size_t)m * D + ch0;
                *(u32x4*)o = (u32x4){w[0], w[1], w[2], w[3]}; *(u32x4*)(o + 8) = (u32x4){w[4], w[5], w[6], w[7]};
            }
        } SEAM(10);
        if (PH_ON(11) && IN(11)) for (int rep_ = 0; rep_ < NREP(11); ++rep_) { if (rep_) xcd_barrier(xbar);
            pg8::Gemm g{R0, (const bf16_t*)(ws + WS_WOUT), MX, D, D, D}; pg8::StaticOrder S; S.init(MX, D, G, bid);
            EpiResid E{Yx, Yc, Yx, Yc, st1, lng, lnb, modv, 5, 1.0f};
            pg8::gemm_phase<EpiResid, pg8::StaticOrder>(lds, g, S, E);
        } SEAM(11);
        if (PH_ON(12) && IN(12)) for (int rep_ = 0; rep_ < NREP(12); ++rep_) { if (rep_) xcd_barrier(xbar); ln_pass<12>(p, lds, ws, Yx, Yc, modv, lng, lnb, st1, st2, R0, gw, NGW, lane, wave); } SEAM(12);
        if (PH_ON(13) && IN(13)) for (int rep_ = 0; rep_ < NREP(13); ++rep_) { if (rep_) xcd_barrier(xbar);
            pg8::Gemm g{R0, (const bf16_t*)(ws + WS_WIB), MX, NWI, D, D}; pg8::StaticOrder S; S.init(MX, NWI, G, bid);
            EpiSwiglu E{(bf16_t*)(ws + WS_R1)};
            pg8::gemm_phase<EpiSwiglu, pg8::StaticOrder>(lds, g, S, E);
        } SEAM(13);
        if (PH_ON(14) && IN(14)) for (int rep_ = 0; rep_ < NREP(14); ++rep_) { if (rep_) xcd_barrier(xbar);
            pg8::Gemm g{(const bf16_t*)(ws + WS_R1), (const bf16_t*)(ws + WS_WOB), MX, D, DFF, DFF}; pg8::StaticOrder S; S.init(MX, D, G, bid);
            EpiResid E{Yx, Yc, Yx, Yc, st2, lng + D, lnb + D, modv, 8, 0.5f};
            pg8::gemm_phase<EpiResid, pg8::StaticOrder>(lds, g, S, E);
        } SEAM(14);
        if (PH_ON(15) && IN(15)) for (int rep_ = 0; rep_ < NREP(15); ++rep_) { if (rep_) xcd_barrier(xbar);
            const float* lg = lng + 2 * D; const float* lb = lnb + 2 * D;
            LAS float* Lg = (LAS float*)lds; LAS float* Lb = Lg + D;
            *(LAS f32x4*)(Lg + tid * 4) = *(const f32x4*)(lg + tid * 4); *(LAS f32x4*)(Lb + tid * 4) = *(const f32x4*)(lb + tid * 4);
            __syncthreads();
            f32x4 nv[8];
#pragma unroll
            for (int q = 0; q < 8; ++q) nv[q] = *(const f32x4*)(Yx + (size_t)gw * D + q * 256 + lane * 4);
            for (int m = gw; m < MX; m += NGW) {
                float* yr = Yx + (size_t)m * D;
                f32x4 v[8]; float s = 0.f;
#pragma unroll
                for (int q = 0; q < 8; ++q) { v[q] = nv[q]; s += (v[q][0] + v[q][1]) + (v[q][2] + v[q][3]); }
                { const int mn = m + NGW < MX ? m + NGW : m;
#pragma unroll
                  for (int q = 0; q < 8; ++q) nv[q] = *(const f32x4*)(Yx + (size_t)mn * D + q * 256 + lane * 4); }
                const float mean = wave_sum(s) * (1.0f / D); float s2 = 0.f;
#pragma unroll
                for (int q = 0; q < 8; ++q) { v[q] = v[q] - mean; s2 += (v[q][0] * v[q][0] + v[q][1] * v[q][1]) + (v[q][2] * v[q][2] + v[q][3] * v[q][3]); }
                const float rstd = 1.0f / sqrtf(wave_sum(s2) * (1.0f / D) + LN_EPS);
                f32x4 g8[8], b8[8];
#pragma unroll
                for (int q = 0; q < 8; ++q) { const int c = q * 256 + lane * 4; g8[q] = *(const LAS f32x4*)(Lg + c); b8[q] = *(const LAS f32x4*)(Lb + c); }
#pragma unroll
                for (int q = 0; q < 8; ++q) { const int c = q * 256 + lane * 4; *(f32x4*)(yr + c) = v[q] * rstd * g8[q] + b8[q]; }
            }
        } SEAM(15);
#undef IN
#undef SEAM
}

extern "C" void kernel_launch(void* const* d_in, const int* in_sizes, int n_in, void* d_out, int out_size, void* d_ws, size_t ws_size, hipStream_t stream) {
    static int grid = 0;
    if (grid == 0) {
        int dev = 0, cus = 0, per_cu = 0;
        hipGetDevice(&dev);
        hipDeviceGetAttribute(&cus, hipDeviceAttributeMultiprocessorCount, dev);
        hipFuncSetAttribute((const void*)fwd_megakernel, hipFuncAttributeMaxDynamicSharedMemorySize, LDS_BYTES);
        hipOccupancyMaxActiveBlocksPerMultiprocessor(&per_cu, (const void*)fwd_megakernel, 512, LDS_BYTES);
        if (per_cu < 1) per_cu = 1;
        grid = cus * per_cu;
        if (ws_size < WS_END) fprintf(stderr, "kernel_launch: workspace too small: %zu < %zu\n", ws_size, (size_t)WS_END);
    }
    (void)hipMemsetAsync(d_ws, 0, 16384, stream);
    Params p{};
    for (int i = 0; i < 29; ++i) p.in[i] = (const float*)d_in[i];
    p.out = (float*)d_out; p.ws = (unsigned char*)d_ws;
#if SPLIT_LAUNCH
    for (int ph = 0; ph < 16; ++ph) {
        p.ph_lo = ph; p.ph_hi = ph + 1;
        hipLaunchKernelGGL(fwd_megakernel, dim3(grid), dim3(512), LDS_BYTES, stream, p);
    }
#else
    p.ph_lo = 0; p.ph_hi = 16;
    void* args[] = {&p};
    hipError_t e = hipLaunchCooperativeKernel((const void*)fwd_megakernel, dim3(grid), dim3(512), args, LDS_BYTES, stream);
    if (e != hipSuccess) fprintf(stderr, "cooperative launch failed: %s (grid %d)\n", hipGetErrorString(e), grid);
#endif
}
```
